# Optimizing an MI355X kernel written in HIP

```python
import math
import jax, jax.numpy as jnp
from jax import lax
import numpy as np

D_MODEL = 1024
BATCH = 8
SEQ = 2048
DEPTH = 2

N_META = 16
Q_BLOCK = 128
EPS = 1e-6

SSM_WIDTH = 256
SSM_GROUP = 16
SSM_GROUPS = SSM_WIDTH // SSM_GROUP
SSM_STATE = 64
DIFF_HEADS = 4
DIFF_QK_DIM = 64
DIFF_V_DIM = 2 * DIFF_QK_DIM
DIFF_WIDTH = DIFF_HEADS * DIFF_V_DIM
FOX_HEADS = 4
FOX_HEAD_DIM = 64
FOX_WIDTH = FOX_HEADS * FOX_HEAD_DIM
MIX_WIDTH = SSM_WIDTH + DIFF_WIDTH + FOX_WIDTH
IN_SPLIT = (SSM_WIDTH, DIFF_WIDTH, DIFF_WIDTH, DIFF_WIDTH,
            FOX_WIDTH, FOX_WIDTH, FOX_WIDTH, FOX_HEADS)
IN_WIDTH = SSM_WIDTH + 3 * DIFF_WIDTH + 3 * FOX_WIDTH + FOX_HEADS
D_FF_DENSE = 2816
N_EXPERTS = 8
TOP_K = 2
D_FF_EXPERT = 3584
N_DENSE = (DEPTH + 1) // 2
N_MOE = DEPTH // 2

kernel_name = "hymba_s5_diffattn_fox_moe_trunk"


def _rmsnorm(x, g):
    xf = x.astype(jnp.float32)
    y = xf * lax.rsqrt(jnp.mean(xf * xf, axis=-1, keepdims=True) + EPS)
    return (y * g.astype(jnp.float32)).astype(x.dtype)


def _heads(t, n_heads, *tail):
    return jnp.moveaxis(t.reshape(t.shape[:2] + (n_heads,) + tail), 2, 1)


def _merge_heads(o):
    b, h, l, d = o.shape
    return jnp.moveaxis(o, 1, 2).reshape(b, l, h * d)


def _block_sweep(block_fn, q_args, n_meta):
    L = q_args[0].shape[2]
    pos = jnp.arange(L, dtype=jnp.int32)
    meta_out = block_fn(*[a[:, :, :n_meta] for a in q_args], pos[:n_meta])
    n_blk = (L - n_meta) // Q_BLOCK

    def to_blocks(a):
        r = a[:, :, n_meta:]
        r = r.reshape(r.shape[:2] + (n_blk, Q_BLOCK) + r.shape[3:])
        return jnp.moveaxis(r, 2, 0)

    blocks = tuple(to_blocks(a) for a in q_args) + (pos[n_meta:].reshape(n_blk, Q_BLOCK),)
    real = lax.map(lambda args: block_fn(*args), blocks)
    real = jnp.moveaxis(real, 0, 2)
    real = real.reshape(real.shape[:2] + (n_blk * Q_BLOCK,) + real.shape[4:])
    return jnp.concatenate([meta_out, real], axis=2)


def _complex_affine_combine(e1, e2):
    ar1, ai1, br1, bi1 = e1
    ar2, ai2, br2, bi2 = e2
    ar = ar2 * ar1 - ai2 * ai1
    ai = ar2 * ai1 + ai2 * ar1
    br = ar2 * br1 - ai2 * bi1 + br2
    bi = ar2 * bi1 + ai2 * br1 + bi2
    return (ar, ai, br, bi)


def _s5(u, lam_re, lam_im, log_dt, b_re, b_im, c_re, c_im, d_skip, w_glu):
    bsz, L, _ = u.shape
    f32 = jnp.float32
    uf = u.astype(f32).reshape(bsz, L, SSM_GROUPS, SSM_GROUP)
    dt = jnp.exp(log_dt.astype(f32))[:, None]
    lr = lam_re.astype(f32)
    li = lam_im.astype(f32)
    mag = jnp.exp(lr * dt)
    ab_re = mag * jnp.cos(li * dt)
    ab_im = mag * jnp.sin(li * dt)
    den = lr * lr + li * li
    nr = ab_re - 1.0
    ni = ab_im
    coef_re = (nr * lr + ni * li) / den
    coef_im = (ni * lr - nr * li) / den
    bu_r = jnp.einsum('blgc,gnc->blgn', uf, b_re.astype(f32))
    bu_i = jnp.einsum('blgc,gnc->blgn', uf, b_im.astype(f32))
    bu_re = coef_re * bu_r - coef_im * bu_i
    bu_im = coef_re * bu_i + coef_im * bu_r
    shape = bu_re.shape
    a_re = jnp.broadcast_to(ab_re, shape)
    a_im = jnp.broadcast_to(ab_im, shape)
    _, _, x_re, x_im = lax.associative_scan(_complex_affine_combine,
                                            (a_re, a_im, bu_re, bu_im), axis=1)
    y = (jnp.einsum('blgn,gcn->blgc', x_re, c_re.astype(f32))
         - jnp.einsum('blgn,gcn->blgc', x_im, c_im.astype(f32))
         + d_skip.astype(f32) * uf)
    y = jax.nn.gelu(y.reshape(bsz, L, SSM_WIDTH))
    g = y @ w_glu.astype(f32)
    out = g[..., :SSM_WIDTH] * jax.nn.sigmoid(g[..., SSM_WIDTH:])
    return out.astype(u.dtype)


def _diff_attention(q, k, v, lam, lam_init, subln_g):
    f32 = jnp.float32
    L = k.shape[2]
    k_pos = jnp.arange(L, dtype=jnp.int32)
    scale = DIFF_QK_DIM ** -0.5
    vf = v.astype(f32)

    def block(qb, q_pos):
        s = jnp.einsum('bhqmd,bhkmd->bhmqk', qb, k, preferred_element_type=f32) * scale
        mask = k_pos[None, :] <= q_pos[:, None]
        p = jax.nn.softmax(jnp.where(mask, s, -jnp.inf), axis=-1)
        a = p[:, :, 0] - lam * p[:, :, 1]
        return jnp.einsum('bhqk,bhkd->bhqd', a, vf)

    o = _block_sweep(block, (q,), N_META)
    o = _rmsnorm(o, subln_g) * (1.0 - lam_init)
    return _merge_heads(o)


def _forgetting_attention(q, k, v, log_f):
    f32 = jnp.float32
    L = k.shape[2]
    k_pos = jnp.arange(L, dtype=jnp.int32)
    scale = FOX_HEAD_DIM ** -0.5
    cum = jnp.cumsum(log_f, axis=-1)
    vf = v.astype(f32)

    def block(qb, cq, q_pos):
        s = jnp.einsum('bhqd,bhkd->bhqk', qb, k, preferred_element_type=f32) * scale
        s = s + cq[..., :, None] - cum[:, :, None, :]
        mask = k_pos[None, :] <= q_pos[:, None]
        p = jax.nn.softmax(jnp.where(mask, s, -jnp.inf), axis=-1)
        return jnp.einsum('bhqk,bhkd->bhqd', p, vf)

    o = _block_sweep(block, (q, cum), N_META)
    return _merge_heads(o)


def _swiglu(h, w1, w3, w2):
    return (jax.nn.silu(h @ w1) * (h @ w3)) @ w2


def _moe(h, w_router, w1, w3, w2):
    f32 = jnp.float32
    logits = (h @ w_router).astype(f32)
    top_v, top_i = lax.top_k(logits, TOP_K)
    gw = jax.nn.softmax(top_v, axis=-1)
    gate = jnp.sum(jax.nn.one_hot(top_i, N_EXPERTS, dtype=f32) * gw[..., None], axis=-2)
    y = jnp.zeros(h.shape, f32)
    for e in range(N_EXPERTS):
        y = y + gate[..., e:e + 1] * _swiglu(h, w1[e], w3[e], w2[e]).astype(f32)
    return y.astype(h.dtype)


def setup_inputs(seed: int = 0) -> dict:
    key = jax.random.key(seed)
    ks = jax.random.split(key, 32)
    f32 = jnp.float32
    nrm = lambda k, shape, s: jax.random.normal(k, shape, f32) * s
    n_idx = jnp.arange(SSM_STATE, dtype=f32)
    lam_re = -0.5 + nrm(ks[5], (DEPTH, SSM_GROUPS, SSM_STATE), 0.01)
    lam_im = math.pi * n_idx + nrm(ks[6], (DEPTH, SSM_GROUPS, SSM_STATE), 0.01)
    return {
        "x": nrm(ks[0], (BATCH, SEQ, D_MODEL), 1.0),
        "meta_tokens": nrm(ks[1], (N_META, D_MODEL), 1.0),
        "norm_mix_g": 1.0 + nrm(ks[2], (DEPTH, D_MODEL), 0.02),
        "w_in": nrm(ks[3], (DEPTH, D_MODEL, IN_WIDTH), D_MODEL ** -0.5),
        "w_out": nrm(ks[4], (DEPTH, MIX_WIDTH, D_MODEL), MIX_WIDTH ** -0.5),
        "ssm_lambda_re": lam_re,
        "ssm_lambda_im": lam_im,
        "ssm_log_dt": jax.random.uniform(ks[7], (DEPTH, SSM_GROUPS), f32,
                                         math.log(1e-3), math.log(1e-1)),
        "ssm_b_re": nrm(ks[8], (DEPTH, SSM_GROUPS, SSM_STATE, SSM_GROUP), (2 * SSM_GROUP) ** -0.5),
        "ssm_b_im": nrm(ks[9], (DEPTH, SSM_GROUPS, SSM_STATE, SSM_GROUP), (2 * SSM_GROUP) ** -0.5),
        "ssm_c_re": nrm(ks[10], (DEPTH, SSM_GROUPS, SSM_GROUP, SSM_STATE), (2 * SSM_STATE) ** -0.5),
        "ssm_c_im": nrm(ks[11], (DEPTH, SSM_GROUPS, SSM_GROUP, SSM_STATE), (2 * SSM_STATE) ** -0.5),
        "ssm_d": nrm(ks[12], (DEPTH, SSM_GROUPS, SSM_GROUP), 1.0),
        "ssm_w_glu": nrm(ks[13], (DEPTH, SSM_WIDTH, 2 * SSM_WIDTH), SSM_WIDTH ** -0.5),
        "diff_lambda_q1": nrm(ks[14], (DEPTH, DIFF_QK_DIM), 0.1),
        "diff_lambda_k1": nrm(ks[15], (DEPTH, DIFF_QK_DIM), 0.1),
        "diff_lambda_q2": nrm(ks[16], (DEPTH, DIFF_QK_DIM), 0.1),
        "diff_lambda_k2": nrm(ks[17], (DEPTH, DIFF_QK_DIM), 0.1),
        "diff_subln_g": 1.0 + nrm(ks[18], (DEPTH, DIFF_V_DIM), 0.02),
        "fox_forget_b": jax.random.uniform(ks[19], (DEPTH, FOX_HEADS), f32, 2.0, 5.0),
        "norm_ffn_g": 1.0 + nrm(ks[20], (DEPTH, D_MODEL), 0.02),
        "dense_w1": nrm(ks[21], (N_DENSE, D_MODEL, D_FF_DENSE), D_MODEL ** -0.5),
        "dense_w3": nrm(ks[22], (N_DENSE, D_MODEL, D_FF_DENSE), D_MODEL ** -0.5),
        "dense_w2": nrm(ks[23], (N_DENSE, D_FF_DENSE, D_MODEL), D_FF_DENSE ** -0.5),
        "moe_router": nrm(ks[24], (N_MOE, D_MODEL, N_EXPERTS), D_MODEL ** -0.5),
        "moe_w1": nrm(ks[25], (N_MOE, N_EXPERTS, D_MODEL, D_FF_EXPERT), D_MODEL ** -0.5),
        "moe_w3": nrm(ks[26], (N_MOE, N_EXPERTS, D_MODEL, D_FF_EXPERT), D_MODEL ** -0.5),
        "moe_w2": nrm(ks[27], (N_MOE, N_EXPERTS, D_FF_EXPERT, D_MODEL), D_FF_EXPERT ** -0.5),
        "final_norm_g": 1.0 + nrm(ks[28], (D_MODEL,), 0.02),
    }


def reference(x, meta_tokens, norm_mix_g, w_in, w_out, ssm_lambda_re, ssm_lambda_im,
              ssm_log_dt, ssm_b_re, ssm_b_im, ssm_c_re, ssm_c_im, ssm_d, ssm_w_glu,
              diff_lambda_q1, diff_lambda_k1, diff_lambda_q2, diff_lambda_k2, diff_subln_g,
              fox_forget_b, norm_ffn_g, dense_w1, dense_w3, dense_w2,
              moe_router, moe_w1, moe_w3, moe_w2, final_norm_g):
    f32 = jnp.float32
    bsz = x.shape[0]
    meta = jnp.broadcast_to(meta_tokens[None].astype(x.dtype), (bsz, N_META, D_MODEL))
    res = jnp.concatenate([meta, x], axis=1)
    offs = np.cumsum(np.array(IN_SPLIT))[:-1].tolist()
    for l in range(DEPTH):
        h = _rmsnorm(res, norm_mix_g[l])
        z = h @ w_in[l]
        u, dq, dk, dv, fq, fk, fv, fg = jnp.split(z, offs, axis=-1)

        ssm_out = _s5(u, ssm_lambda_re[l], ssm_lambda_im[l], ssm_log_dt[l],
                      ssm_b_re[l], ssm_b_im[l], ssm_c_re[l], ssm_c_im[l],
                      ssm_d[l], ssm_w_glu[l])

        lam_init = 0.8 - 0.6 * math.exp(-0.3 * l)
        lam = (jnp.exp(jnp.sum(diff_lambda_q1[l].astype(f32) * diff_lambda_k1[l].astype(f32)))
               - jnp.exp(jnp.sum(diff_lambda_q2[l].astype(f32) * diff_lambda_k2[l].astype(f32)))
               + lam_init)
        diff_out = _diff_attention(_heads(dq, DIFF_HEADS, 2, DIFF_QK_DIM),
                                   _heads(dk, DIFF_HEADS, 2, DIFF_QK_DIM),
                                   _heads(dv, DIFF_HEADS, DIFF_V_DIM),
                                   lam, lam_init, diff_subln_g[l])

        log_f = jax.nn.log_sigmoid(fg.astype(f32) + fox_forget_b[l].astype(f32))
        fox_out = _forgetting_attention(_heads(fq, FOX_HEADS, FOX_HEAD_DIM),
                                        _heads(fk, FOX_HEADS, FOX_HEAD_DIM),
                                        _heads(fv, FOX_HEADS, FOX_HEAD_DIM),
                                        jnp.moveaxis(log_f, 2, 1))

        mixed = jnp.concatenate([ssm_out.astype(res.dtype), diff_out.astype(res.dtype),
                                 fox_out.astype(res.dtype)], axis=-1)
        res = res + mixed @ w_out[l]

        h = _rmsnorm(res, norm_ffn_g[l])
        if l % 2 == 0:
            ffn = _swiglu(h, dense_w1[l // 2], dense_w3[l // 2], dense_w2[l // 2])
        else:
            ffn = _moe(h, moe_router[l // 2], moe_w1[l // 2], moe_w3[l // 2], moe_w2[l // 2])
        res = res + ffn
    return _rmsnorm(res, final_norm_g)[:, N_META:]
```

```cpp
#include <hip/hip_runtime.h>
#include <stdint.h>

typedef unsigned short bf16_t;

constexpr int D = 1024, NB = 8, SEQ = 2048, NMETA = 16;
constexpr int MAIN = NB * SEQ;
constexpr int MVALID = MAIN + NMETA;
constexpr int MP = 16640;
constexpr int ZW = 2560, INW = 2564;
constexpr int C_DQ = 256, C_DK = 768, C_DV = 1280, C_FQ = 1792, C_FK = 2048, C_FV = 2304;
constexpr int FFD = 2816, FFE = 3584, NE = 8;
constexpr float EPS = 1e-6f;
constexpr float LOG2E = 1.4426950408889634f;
constexpr float QSCALE = 0.125f * LOG2E;

constexpr size_t MiB = 1u << 20;
constexpr size_t OFF_H = 1 * MiB;
constexpr size_t OFF_Z = 36 * MiB;
constexpr size_t OFF_MIX = 118 * MiB;
constexpr size_t OFF_RESM = 152 * MiB;
constexpr size_t OFF_FG = 153 * MiB;
constexpr size_t OFF_CUM = 154 * MiB;
constexpr size_t OFF_GATE = 155 * MiB;
constexpr size_t OFF_Y = 156 * MiB;
constexpr size_t OFF_X = 165 * MiB;
constexpr size_t OFF_HN = 165 * MiB;

__device__ __forceinline__ float bf2f(bf16_t v) { return __uint_as_float(((unsigned)v) << 16); }
__device__ __forceinline__ bf16_t f2bf(float f) { unsigned u = __float_as_uint(f); return (bf16_t)((u + 0x7fffu + ((u >> 16) & 1u)) >> 16); }
__device__ __forceinline__ float wave_sum(float v) {
#pragma unroll
    for (int o = 32; o > 0; o >>= 1) v += __shfl_xor(v, o);
    return v;
}
__device__ __forceinline__ float wave_max(float v) {
#pragma unroll
    for (int o = 32; o > 0; o >>= 1) v = fmaxf(v, __shfl_xor(v, o));
    return v;
}

struct RowSrc { const float* x; const float* meta; const float* dout; const float* resm; int layer0; int pad; };
__device__ __forceinline__ const float* res_row(const RowSrc& s, int r) {
    if (s.layer0) { int mr = r - MAIN; if (mr > NMETA - 1) mr = NMETA - 1; return r < MAIN ? s.x + (size_t)r * D : s.meta + (size_t)mr * D; }
    return r < MAIN ? s.dout + (size_t)r * D : s.resm + (size_t)(r - MAIN) * D;
}

__global__ __launch_bounds__(256) void k_norm(RowSrc s, const float* __restrict__ g, const float* __restrict__ wfg  ,
                                              bf16_t* __restrict__ hbuf, float* __restrict__ fgbuf,
                                              const float* __restrict__ wr  , float* __restrict__ gates) {
    const int lane = threadIdx.x & 63;
    const int gw = (blockIdx.x * blockDim.x + threadIdx.x) >> 6, nw = (gridDim.x * blockDim.x) >> 6;
    for (int r = gw; r < MP; r += nw) {
        unsigned long long* o8 = (unsigned long long*)(hbuf + (size_t)r * D) + lane;
        if (r >= MVALID) {
#pragma unroll
            for (int j = 0; j < 4; ++j) o8[64 * j] = 0ull;
            continue;
        }
        const float4* p = (const float4*)res_row(s, r) + lane;
        float4 v[4]; float ss = 0.f;
#pragma unroll
        for (int j = 0; j < 4; ++j) { v[j] = p[64 * j]; ss += v[j].x * v[j].x + v[j].y * v[j].y + v[j].z * v[j].z + v[j].w * v[j].w; }
        ss = wave_sum(ss);
        const float rstd = 1.0f / sqrtf(ss * (1.0f / D) + EPS);
#pragma unroll
        for (int j = 0; j < 4; ++j) {
            const float4 gj = ((const float4*)g)[lane + 64 * j];
            v[j].x = v[j].x * rstd * gj.x; v[j].y = v[j].y * rstd * gj.y; v[j].z = v[j].z * rstd * gj.z; v[j].w = v[j].w * rstd * gj.w;
            o8[64 * j] = (unsigned long long)f2bf(v[j].x) | ((unsigned long long)f2bf(v[j].y) << 16) | ((unsigned long long)f2bf(v[j].z) << 32) | ((unsigned long long)f2bf(v[j].w) << 48);
        }
        if (wfg) {
            float a[4] = {0.f, 0.f, 0.f, 0.f};
#pragma unroll
            for (int j = 0; j < 4; ++j) {
                const int k = 256 * j + 4 * lane;
                const float hv[4] = {v[j].x, v[j].y, v[j].z, v[j].w};
#pragma unroll
                for (int i = 0; i < 4; ++i) {
                    const float4 w = *(const float4*)(wfg + (size_t)(k + i) * INW);
                    a[0] += hv[i] * w.x; a[1] += hv[i] * w.y; a[2] += hv[i] * w.z; a[3] += hv[i] * w.w;
                }
            }
#pragma unroll
            for (int c = 0; c < 4; ++c) a[c] = wave_sum(a[c]);
            if (lane == 0) *(float4*)(fgbuf + (size_t)r * 4) = make_float4(a[0], a[1], a[2], a[3]);
        }
        if (wr && r < MAIN) {
            float a[8];
#pragma unroll
            for (int e = 0; e < 8; ++e) a[e] = 0.f;
#pragma unroll
            for (int j = 0; j < 4; ++j) {
                const int k = 256 * j + 4 * lane;
                const float hv[4] = {v[j].x, v[j].y, v[j].z, v[j].w};
#pragma unroll
                for (int i = 0; i < 4; ++i) {
                    const float4 w0 = *(const float4*)(wr + (size_t)(k + i) * 8), w1 = *(const float4*)(wr + (size_t)(k + i) * 8 + 4);
                    a[0] += hv[i] * w0.x; a[1] += hv[i] * w0.y; a[2] += hv[i] * w0.z; a[3] += hv[i] * w0.w;
                    a[4] += hv[i] * w1.x; a[5] += hv[i] * w1.y; a[6] += hv[i] * w1.z; a[7] += hv[i] * w1.w;
                }
            }
#pragma unroll
            for (int e = 0; e < 8; ++e) a[e] = wave_sum(a[e]);
            int i1 = 0; float v1 = a[0];
#pragma unroll
            for (int e = 1; e < 8; ++e) if (a[e] > v1) { v1 = a[e]; i1 = e; }
            int i2 = -1; float v2 = -3.0e38f;
#pragma unroll
            for (int e = 0; e < 8; ++e) if (e != i1 && a[e] > v2) { v2 = a[e]; i2 = e; }
            const float g1 = 1.0f / (1.0f + expf(v2 - v1)), g2 = 1.0f - g1;
            if (lane < 8) gates[(size_t)r * 8 + lane] = lane == i1 ? g1 : (lane == i2 ? g2 : 0.f);
        }
    }
}

__device__ __forceinline__ float log_sigmoid(float x) { return fminf(x, 0.f) - log1pf(expf(-fabsf(x))); }
__global__ void k_cum(const float* __restrict__ fg, const float* __restrict__ bias, float* __restrict__ cum) {
    const int t = blockIdx.x * blockDim.x + threadIdx.x;
    if (t >= NB * 4) return;
    const int b = t >> 2, h = t & 3; const float bi = bias[h];
    float c = 0.f;
    for (int j = 0; j < NMETA; ++j) { c += log_sigmoid(fg[(size_t)(MAIN + j) * 4 + h] + bi); if (b == 0) cum[(size_t)(MAIN + j) * 4 + h] = c * LOG2E; }
    for (int t0 = 0; t0 < SEQ; t0 += 16) {
        float f[16];
#pragma unroll
        for (int i = 0; i < 16; ++i) f[i] = fg[(size_t)(b * SEQ + t0 + i) * 4 + h];
#pragma unroll
        for (int i = 0; i < 16; ++i) { c += log_sigmoid(f[i] + bi); cum[(size_t)(b * SEQ + t0 + i) * 4 + h] = c * LOG2E; }
    }
}

template <class Epi, bool DUAL>
__global__ __launch_bounds__(512) void k_gemm(const bf16_t* __restrict__ A, int lda, const float* __restrict__ W1, const float* __restrict__ W2, int ldw,
                                              int M, int N, int K, Epi epi) {
    __shared__ float As[16][132];
    __shared__ float B1s[16][132];
    __shared__ float B2s[DUAL ? 16 : 1][132];
    const int tid = threadIdx.x, tx = tid & 15, ty = tid >> 4;
    const int ntm = M / 128, ntn = N / 128;
    for (int tile = blockIdx.x; tile < ntm * ntn; tile += gridDim.x) {
        const int tm = tile / ntn, tn = tile % ntn, m0 = tm * 128, n0 = tn * 128;
        float acc1[4][8], acc2[4][8];
#pragma unroll
        for (int i = 0; i < 4; ++i)
#pragma unroll
            for (int j = 0; j < 8; ++j) { acc1[i][j] = 0.f; acc2[i][j] = 0.f; }
        for (int k0 = 0; k0 < K; k0 += 16) {
            {
                const int row = tid >> 2, kq = tid & 3;
                const uint2 av = *(const uint2*)(A + (size_t)(m0 + row) * lda + k0 + 4 * kq);
                As[4 * kq + 0][row] = __uint_as_float(av.x << 16); As[4 * kq + 1][row] = __uint_as_float(av.x & 0xffff0000u);
                As[4 * kq + 2][row] = __uint_as_float(av.y << 16); As[4 * kq + 3][row] = __uint_as_float(av.y & 0xffff0000u);
                const int kk = tid >> 5, nq = tid & 31;
                const float4 b1 = *(const float4*)(W1 + (size_t)(k0 + kk) * ldw + n0 + 4 * nq);
                *(float4*)&B1s[kk][4 * nq] = b1;
                if (DUAL) { const float4 b2 = *(const float4*)(W2 + (size_t)(k0 + kk) * ldw + n0 + 4 * nq); *(float4*)&B2s[kk][4 * nq] = b2; }
            }
            __syncthreads();
#pragma unroll
            for (int kk = 0; kk < 16; ++kk) {
                const float4 a4 = *(const float4*)&As[kk][ty * 4];
                const float a[4] = {a4.x, a4.y, a4.z, a4.w};
                const float4 b0 = *(const float4*)&B1s[kk][tx * 8], b1 = *(const float4*)&B1s[kk][tx * 8 + 4];
                const float b[8] = {b0.x, b0.y, b0.z, b0.w, b1.x, b1.y, b1.z, b1.w};
#pragma unroll
                for (int i = 0; i < 4; ++i)
#pragma unroll
                    for (int j = 0; j < 8; ++j) acc1[i][j] += a[i] * b[j];
                if (DUAL) {
                    const float4 c0 = *(const float4*)&B2s[kk][tx * 8], c1 = *(const float4*)&B2s[kk][tx * 8 + 4];
                    const float c[8] = {c0.x, c0.y, c0.z, c0.w, c1.x, c1.y, c1.z, c1.w};
#pragma unroll
                    for (int i = 0; i < 4; ++i)
#pragma unroll
                        for (int j = 0; j < 8; ++j) acc2[i][j] += a[i] * c[j];
                }
            }
            __syncthreads();
        }
#pragma unroll
        for (int i = 0; i < 4; ++i)
#pragma unroll
            for (int j = 0; j < 8; ++j) epi(m0 + ty * 4 + i, n0 + tx * 8 + j, acc1[i][j], acc2[i][j]);
    }
}
struct EpiZ { bf16_t* z; __device__ void operator()(int m, int n, float a, float) const {
    const float sc = ((n >= C_DQ && n < C_DK) || (n >= C_FQ && n < C_FK)) ? QSCALE : 1.0f; z[(size_t)m * ZW + n] = f2bf(a * sc); } };
struct EpiRes { RowSrc src; float* dout; float* resm; __device__ void operator()(int m, int n, float a, float) const {
    const float base = res_row(src, m)[n]; float* o = m < MAIN ? dout + (size_t)m * D : resm + (size_t)(m - MAIN) * D; o[n] = base + a; } };
struct EpiSwiglu { bf16_t* h; int ldh; int pad; __device__ void operator()(int m, int n, float a, float b) const { h[(size_t)m * ldh + n] = f2bf(a / (1.0f + expf(-a)) * b); } };
struct EpiGlu { bf16_t* mix; __device__ void operator()(int m, int n, float a, float b) const { mix[(size_t)m * D + n] = f2bf(a / (1.0f + expf(-b))); } };
struct EpiMoeDown { const float* gates; float* dout; int e; int pad; __device__ void operator()(int m, int n, float a, float) const { dout[(size_t)m * D + n] += gates[(size_t)m * 8 + e] * a; } };

__device__ __forceinline__ double exp_small(double x) {
    const double y = x * (1.0 / 1024.0); double t = 1.0, s = 1.0;
#pragma unroll
    for (int i = 1; i <= 10; ++i) { t = t * y / (double)i; s += t; }
#pragma unroll
    for (int i = 0; i < 10; ++i) s = s * s;
    return s;
}
__device__ __forceinline__ void sincos_d(double x, double& sn, double& cs) {
    const double TWO_PI = 6.283185307179586476925;
    const double k = rint(x / TWO_PI); const double r = x - k * TWO_PI, r2 = r * r;
    double ts = r, tc = 1.0; sn = r; cs = 1.0;
#pragma unroll
    for (int i = 1; i <= 15; ++i) { tc = -tc * r2 / (double)((2 * i - 1) * (2 * i)); cs += tc; ts = -ts * r2 / (double)((2 * i) * (2 * i + 1)); sn += ts; }
}
__device__ __forceinline__ void ssm_consts(const float* lam_re, const float* lam_im, const float* log_dt, int g, int n, float& are, float& aim, float& cre, float& cim) {
    const double dt = exp_small((double)log_dt[g]);
    const double lr = (double)lam_re[g * 64 + n], li = (double)lam_im[g * 64 + n];
    const double mag = exp_small(lr * dt); double sn, cs; sincos_d(li * dt, sn, cs);
    const double ar = mag * cs, ai = mag * sn, den = lr * lr + li * li, nr = ar - 1.0, ni = ai;
    are = (float)ar; aim = (float)ai; cre = (float)((nr * lr + ni * li) / den); cim = (float)((ni * lr - nr * li) / den);
}
__global__ __launch_bounds__(64) void k_ssm_scan(const bf16_t* __restrict__ z, const float* lam_re, const float* lam_im, const float* log_dt,
                                                 const float* __restrict__ b_re, const float* __restrict__ b_im, float2* __restrict__ X) {
    const int t = blockIdx.x * 64 + threadIdx.x;
    const int n = t & 63, g = (t >> 6) & 15, b = t >> 10;
    float are, aim, cre, cim; ssm_consts(lam_re, lam_im, log_dt, g, n, are, aim, cre, cim);
    float br[16], bi[16];
#pragma unroll
    for (int c = 0; c < 16; ++c) { const float r = b_re[(g * 64 + n) * 16 + c], i = b_im[(g * 64 + n) * 16 + c]; br[c] = cre * r - cim * i; bi[c] = cre * i + cim * r; }
    float xr = 0.f, xi = 0.f;
    for (int s = 0; s < NMETA + SEQ; ++s) {
        const int row = s < NMETA ? MAIN + s : b * SEQ + (s - NMETA);
        const uint4 u0 = *(const uint4*)(z + (size_t)row * ZW + 16 * g), u1 = *(const uint4*)(z + (size_t)row * ZW + 16 * g + 8);
        const unsigned uw[8] = {u0.x, u0.y, u0.z, u0.w, u1.x, u1.y, u1.z, u1.w};
        float pr = 0.f, pi = 0.f;
#pragma unroll
        for (int c = 0; c < 8; ++c) { const float lo = __uint_as_float(uw[c] << 16), hi = __uint_as_float(uw[c] & 0xffff0000u);
            pr += lo * br[2 * c] + hi * br[2 * c + 1]; pi += lo * bi[2 * c] + hi * bi[2 * c + 1]; }
        const float nxr = are * xr - aim * xi + pr, nxi = are * xi + aim * xr + pi; xr = nxr; xi = nxi;
        if (s >= NMETA || b == 0) X[(size_t)row * 1024 + g * 64 + n] = make_float2(xr, xi);
    }
}
__device__ __forceinline__ float gelu_tanh(float x) { return 0.5f * x * (1.0f + tanhf(0.7978845608028654f * (x + 0.044715f * x * x * x))); }
__global__ __launch_bounds__(256) void k_ssm_y(const float2* __restrict__ X, const bf16_t* __restrict__ z, const float* __restrict__ c_re, const float* __restrict__ c_im,
                                               const float* __restrict__ dsk, bf16_t* __restrict__ ybuf) {
    const int row = blockIdx.x, ch = threadIdx.x, g = ch >> 4, c = ch & 15;
    if (row >= MVALID) return;
    const float2* xr = X + (size_t)row * 1024 + g * 64; const float* cr = c_re + (g * 16 + c) * 64; const float* ci = c_im + (g * 16 + c) * 64;
    float y = 0.f;
    for (int n = 0; n < 64; ++n) { const float2 x = xr[n]; y += x.x * cr[n] - x.y * ci[n]; }
    y += dsk[g * 16 + c] * bf2f(z[(size_t)row * ZW + ch]);
    ybuf[(size_t)row * 256 + ch] = f2bf(gelu_tanh(y));
}

__device__ __forceinline__ void attn_map(const bf16_t* __restrict__ z, const float* __restrict__ cum, int r, int b, int nk, int qcol, int kcol, int vcol, bool two_v, int bias_h,
                                         float* sc, int lane, float& o0, float& o1) {
    float q[64];
    {
        const uint4* qp = (const uint4*)(z + (size_t)r * ZW + qcol);
#pragma unroll
        for (int i = 0; i < 8; ++i) { const uint4 w = qp[i]; const unsigned ww[4] = {w.x, w.y, w.z, w.w};
#pragma unroll
            for (int j = 0; j < 4; ++j) { q[8 * i + 2 * j] = __uint_as_float(ww[j] << 16); q[8 * i + 2 * j + 1] = __uint_as_float(ww[j] & 0xffff0000u); } }
    }
    const float cq = bias_h >= 0 ? cum[(size_t)r * 4 + bias_h] : 0.f;
    float mx = -3.0e38f;
    for (int k = lane; k < nk; k += 64) {
        const int kr = k < NMETA ? MAIN + k : b * SEQ + (k - NMETA);
        const uint4* kp = (const uint4*)(z + (size_t)kr * ZW + kcol);
        float s = 0.f;
#pragma unroll
        for (int i = 0; i < 8; ++i) { const uint4 w = kp[i]; const unsigned ww[4] = {w.x, w.y, w.z, w.w};
#pragma unroll
            for (int j = 0; j < 4; ++j) s += q[8 * i + 2 * j] * __uint_as_float(ww[j] << 16) + q[8 * i + 2 * j + 1] * __uint_as_float(ww[j] & 0xffff0000u); }
        if (bias_h >= 0) s += cq - cum[(size_t)kr * 4 + bias_h];
        sc[k] = s; mx = fmaxf(mx, s);
    }
    mx = wave_max(mx);
    asm volatile("s_waitcnt lgkmcnt(0)" ::: "memory");
    float sum = 0.f;
    for (int k = lane; k < nk; k += 64) { const float p = exp2f(sc[k] - mx); sc[k] = p; sum += p; }
    sum = wave_sum(sum);
    asm volatile("s_waitcnt lgkmcnt(0)" ::: "memory");
    float a0 = 0.f, a1 = 0.f;
    for (int k = 0; k < nk; ++k) {
        const int kr = k < NMETA ? MAIN + k : b * SEQ + (k - NMETA);
        const float p = sc[k];
        a0 += p * bf2f(z[(size_t)kr * ZW + vcol + lane]);
        if (two_v) a1 += p * bf2f(z[(size_t)kr * ZW + vcol + 64 + lane]);
    }
    asm volatile("s_waitcnt lgkmcnt(0)" ::: "memory");
    const float inv = 1.0f / sum; o0 = a0 * inv; o1 = a1 * inv;
}
__global__ __launch_bounds__(256) void k_final(float* __restrict__ dout, const float* __restrict__ g) {
    const int lane = threadIdx.x & 63;
    const int gw = (blockIdx.x * blockDim.x + threadIdx.x) >> 6, nw = (gridDim.x * blockDim.x) >> 6;
    for (int r = gw; r < MAIN; r += nw) {
        float4* p = (float4*)(dout + (size_t)r * D) + lane;
        float4 v[4]; float ss = 0.f;
#pragma unroll
        for (int j = 0; j < 4; ++j) { v[j] = p[64 * j]; ss += v[j].x * v[j].x + v[j].y * v[j].y + v[j].z * v[j].z + v[j].w * v[j].w; }
        ss = wave_sum(ss);
        const float rstd = 1.0f / sqrtf(ss * (1.0f / D) + EPS);
#pragma unroll
        for (int j = 0; j < 4; ++j) { const float4 gj = ((const float4*)g)[lane + 64 * j];
            p[64 * j] = make_float4(v[j].x * rstd * gj.x, v[j].y * rstd * gj.y, v[j].z * rstd * gj.z, v[j].w * rstd * gj.w); }
    }
}

__global__ void k_lam(const float* q1, const float* k1, const float* q2, const float* k2, float* out) {
    const int l = threadIdx.x; if (l >= 2) return;
    float s1 = 0.f, s2 = 0.f; for (int i = 0; i < 64; ++i) { s1 += q1[l * 64 + i] * k1[l * 64 + i]; s2 += q2[l * 64 + i] * k2[l * 64 + i]; }
    const float lam_init = 0.8f - 0.6f * expf(-0.3f * (float)l);
    out[2 * l] = expf(s1) - expf(s2) + lam_init; out[2 * l + 1] = 1.0f - lam_init;
}
__global__ __launch_bounds__(256) void k_attn_naive_l(const bf16_t* __restrict__ z, const float* __restrict__ cum, const float* __restrict__ lamp, const float* __restrict__ subg, bf16_t* __restrict__ mix);

extern "C" void kernel_launch(void* const* d_in, const int* in_sizes, int n_in, void* d_out, int out_size, void* d_ws, size_t ws_size, hipStream_t stream) {
    const float* x = (const float*)d_in[0]; const float* meta = (const float*)d_in[1]; const float* norm_mix_g = (const float*)d_in[2];
    const float* w_in = (const float*)d_in[3]; const float* w_out = (const float*)d_in[4];
    const float* lam_re = (const float*)d_in[5]; const float* lam_im = (const float*)d_in[6]; const float* log_dt = (const float*)d_in[7];
    const float* b_re = (const float*)d_in[8]; const float* b_im = (const float*)d_in[9]; const float* c_re = (const float*)d_in[10]; const float* c_im = (const float*)d_in[11];
    const float* ssm_d = (const float*)d_in[12]; const float* w_glu = (const float*)d_in[13];
    const float* dq1 = (const float*)d_in[14]; const float* dk1 = (const float*)d_in[15]; const float* dq2 = (const float*)d_in[16]; const float* dk2 = (const float*)d_in[17];
    const float* subln_g = (const float*)d_in[18]; const float* fox_b = (const float*)d_in[19]; const float* norm_ffn_g = (const float*)d_in[20];
    const float* dw1 = (const float*)d_in[21]; const float* dw3 = (const float*)d_in[22]; const float* dw2 = (const float*)d_in[23];
    const float* wrt = (const float*)d_in[24]; const float* mw1 = (const float*)d_in[25]; const float* mw3 = (const float*)d_in[26]; const float* mw2 = (const float*)d_in[27];
    const float* final_g = (const float*)d_in[28];
    char* ws = (char*)d_ws; float* dout = (float*)d_out;
    bf16_t* hbuf = (bf16_t*)(ws + OFF_H); bf16_t* zbuf = (bf16_t*)(ws + OFF_Z); bf16_t* mix = (bf16_t*)(ws + OFF_MIX);
    float* resm = (float*)(ws + OFF_RESM); float* fgb = (float*)(ws + OFF_FG); float* cum = (float*)(ws + OFF_CUM); float* gates = (float*)(ws + OFF_GATE);
    bf16_t* ybuf = (bf16_t*)(ws + OFF_Y); float2* X = (float2*)(ws + OFF_X); bf16_t* hn = (bf16_t*)(ws + OFF_HN);
    float* lamp = (float*)ws;
    const int MG = 16512;
    hipLaunchKernelGGL(k_lam, dim3(1), dim3(64), 0, stream, dq1, dk1, dq2, dk2, lamp);
    for (int l = 0; l < 2; ++l) {
        RowSrc src{}; src.x = x; src.meta = meta; src.dout = dout; src.resm = resm; src.layer0 = (l == 0); src.pad = 0;
        RowSrc cur{}; cur.x = x; cur.meta = meta; cur.dout = dout; cur.resm = resm; cur.layer0 = 0; cur.pad = 0;
        const float* w_in_l = w_in + (size_t)l * D * INW;
        hipLaunchKernelGGL(k_norm, dim3(1024), dim3(256), 0, stream, src, norm_mix_g + l * D, w_in_l + ZW, hbuf, fgb, (const float*)nullptr, (float*)nullptr);
        hipLaunchKernelGGL((k_gemm<EpiZ, false>), dim3(1024), dim3(512), 0, stream, (const bf16_t*)hbuf, D, w_in_l, (const float*)nullptr, INW, MG, ZW, D, EpiZ{zbuf});
        hipLaunchKernelGGL(k_cum, dim3(1), dim3(64), 0, stream, (const float*)fgb, fox_b + l * 4, cum);
        hipLaunchKernelGGL(k_ssm_scan, dim3(NB * 16), dim3(64), 0, stream, (const bf16_t*)zbuf, lam_re + l * 1024, lam_im + l * 1024, log_dt + l * 16,
                           b_re + (size_t)l * 16384, b_im + (size_t)l * 16384, X);
        hipLaunchKernelGGL(k_ssm_y, dim3(MVALID), dim3(256), 0, stream, (const float2*)X, (const bf16_t*)zbuf, c_re + (size_t)l * 16384, c_im + (size_t)l * 16384, ssm_d + l * 256, ybuf);
        hipLaunchKernelGGL((k_gemm<EpiGlu, true>), dim3(1024), dim3(512), 0, stream, (const bf16_t*)ybuf, 256, w_glu + (size_t)l * 256 * 512, w_glu + (size_t)l * 256 * 512 + 256, 512, MG, 256, 256, EpiGlu{mix});
        hipLaunchKernelGGL(k_attn_naive_l, dim3(4096), dim3(256), 0, stream, (const bf16_t*)zbuf, (const float*)cum, (const float*)(lamp + 2 * l), subln_g + l * 128, mix);
        hipLaunchKernelGGL((k_gemm<EpiRes, false>), dim3(1024), dim3(512), 0, stream, (const bf16_t*)mix, D, w_out + (size_t)l * D * D, (const float*)nullptr, D, MG, D, D, EpiRes{src, dout, resm});
        if (l == 0) {
            hipLaunchKernelGGL(k_norm, dim3(1024), dim3(256), 0, stream, cur, norm_ffn_g, (const float*)nullptr, hbuf, fgb, (const float*)nullptr, (float*)nullptr);
            hipLaunchKernelGGL((k_gemm<EpiSwiglu, true>), dim3(1024), dim3(512), 0, stream, (const bf16_t*)hbuf, D, dw1, dw3, FFD, MG, FFD, D, EpiSwiglu{hn, FFD, 0});
            hipLaunchKernelGGL((k_gemm<EpiRes, false>), dim3(1024), dim3(512), 0, stream, (const bf16_t*)hn, FFD, dw2, (const float*)nullptr, D, MG, D, FFD, EpiRes{cur, dout, resm});
        } else {
            hipLaunchKernelGGL(k_norm, dim3(1024), dim3(256), 0, stream, cur, norm_ffn_g + D, (const float*)nullptr, hbuf, fgb, wrt, gates);
            for (int e = 0; e < NE; ++e) {
                hipLaunchKernelGGL((k_gemm<EpiSwiglu, true>), dim3(1024), dim3(512), 0, stream, (const bf16_t*)hbuf, D, mw1 + (size_t)e * D * FFE, mw3 + (size_t)e * D * FFE, FFE, MAIN, FFE, D, EpiSwiglu{hn, FFE, 0});
                hipLaunchKernelGGL((k_gemm<EpiMoeDown, false>), dim3(1024), dim3(512), 0, stream, (const bf16_t*)hn, FFE, mw2 + (size_t)e * FFE * D, (const float*)nullptr, D, MAIN, D, FFE, EpiMoeDown{gates, dout, e, 0});
            }
        }
    }
    hipLaunchKernelGGL(k_final, dim3(1024), dim3(256), 0, stream, dout, final_g);
}

__global__ __launch_bounds__(256) void k_attn_naive_l(const bf16_t* __restrict__ z, const float* __restrict__ cum, const float* __restrict__ lamp, const float* __restrict__ subg, bf16_t* __restrict__ mix) {
    __shared__ float scs[4][2080];
    const int lane = threadIdx.x & 63, w = threadIdx.x >> 6;
    const int gw = blockIdx.x * 4 + w, nw = gridDim.x * 4;
    const float lam = lamp[0], oml = lamp[1];
    float* sc = scs[w];
    for (int item = gw; item < MVALID * 8; item += nw) {
        const int r = item >> 3, hv = item & 7;
        int b = 0, nk;
        if (r < MAIN) { b = r / SEQ; nk = NMETA + (r % SEQ) + 1; } else nk = (r - MAIN) + 1;
        if (hv < 4) {
            const int h = hv; float p0, p1, n0, n1;
            attn_map(z, cum, r, b, nk, C_DQ + 128 * h, C_DK + 128 * h, C_DV + 128 * h, true, -1, sc, lane, p0, p1);
            attn_map(z, cum, r, b, nk, C_DQ + 128 * h + 64, C_DK + 128 * h + 64, C_DV + 128 * h, true, -1, sc, lane, n0, n1);
            const float o0 = p0 - lam * n0, o1 = p1 - lam * n1;
            const float ss = wave_sum(o0 * o0 + o1 * o1);
            const float rstd = 1.0f / sqrtf(ss * (1.0f / 128.0f) + EPS);
            mix[(size_t)r * D + 256 + 128 * h + lane] = f2bf(o0 * rstd * subg[lane] * oml);
            mix[(size_t)r * D + 256 + 128 * h + 64 + lane] = f2bf(o1 * rstd * subg[64 + lane] * oml);
        } else {
            const int h = hv - 4; float o0, o1;
            attn_map(z, cum, r, b, nk, C_FQ + 64 * h, C_FK + 64 * h, C_FV + 64 * h, false, h, sc, lane, o0, o1);
            mix[(size_t)r * D + 768 + 64 * h + lane] = f2bf(o0);
        }
    }
}
```

```cpp
#include <hip/hip_runtime.h>
#include <stdint.h>

typedef unsigned short bf16_t;

constexpr int D = 1024, NB = 8, SEQ = 2048, NMETA = 16;
constexpr int MAIN = NB * SEQ;
constexpr int MVALID = MAIN + NMETA;
constexpr int MP = 16640;
constexpr int ZW = 2560, INW = 2564;
constexpr int C_DQ = 256, C_DK = 768, C_DV = 1280, C_FQ = 1792, C_FK = 2048, C_FV = 2304;
constexpr int FFD = 2816, FFE = 3584, NE = 8;
constexpr float EPS = 1e-6f;
constexpr float LOG2E = 1.4426950408889634f;
constexpr float QSCALE = 0.125f * LOG2E;

constexpr size_t MiB = 1u << 20;
__device__ __forceinline__ float bf2f(bf16_t v) { return __uint_as_float(((unsigned)v) << 16); }
__device__ __forceinline__ bf16_t f2bf(float f) { unsigned u = __float_as_uint(f); return (bf16_t)((u + 0x7fffu + ((u >> 16) & 1u)) >> 16); }
__device__ __forceinline__ float wave_sum(float v) {
#pragma unroll
    for (int o = 32; o > 0; o >>= 1) v += __shfl_xor(v, o);
    return v;
}
__device__ __forceinline__ float wave_max(float v) {
#pragma unroll
    for (int o = 32; o > 0; o >>= 1) v = fmaxf(v, __shfl_xor(v, o));
    return v;
}

struct RowSrc { const float* x; const float* meta; const float* dout; const float* resm; int layer0; int pad; };
__device__ __forceinline__ const float* res_row(const RowSrc& s, int r) {
    if (s.layer0) { int mr = r - MAIN; if (mr > NMETA - 1) mr = NMETA - 1; return r < MAIN ? s.x + (size_t)r * D : s.meta + (size_t)mr * D; }
    return r < MAIN ? s.dout + (size_t)r * D : s.resm + (size_t)(r - MAIN) * D;
}

__global__ __launch_bounds__(256) void k_norm(RowSrc s, const float* __restrict__ g, const float* __restrict__ wfg  ,
                                              bf16_t* __restrict__ hbuf, float* __restrict__ fgbuf,
                                              const float* __restrict__ wr  , float* __restrict__ gates) {
    const int lane = threadIdx.x & 63;
    const int gw = (blockIdx.x * blockDim.x + threadIdx.x) >> 6, nw = (gridDim.x * blockDim.x) >> 6;
    for (int r = gw; r < MP; r += nw) {
        unsigned long long* o8 = (unsigned long long*)(hbuf + (size_t)r * D) + lane;
        if (r >= MVALID) {
#pragma unroll
            for (int j = 0; j < 4; ++j) o8[64 * j] = 0ull;
            continue;
        }
        const float4* p = (const float4*)res_row(s, r) + lane;
        float4 v[4]; float ss = 0.f;
#pragma unroll
        for (int j = 0; j < 4; ++j) { v[j] = p[64 * j]; ss += v[j].x * v[j].x + v[j].y * v[j].y + v[j].z * v[j].z + v[j].w * v[j].w; }
        ss = wave_sum(ss);
        const float rstd = 1.0f / sqrtf(ss * (1.0f / D) + EPS);
#pragma unroll
        for (int j = 0; j < 4; ++j) {
            const float4 gj = ((const float4*)g)[lane + 64 * j];
            v[j].x = v[j].x * rstd * gj.x; v[j].y = v[j].y * rstd * gj.y; v[j].z = v[j].z * rstd * gj.z; v[j].w = v[j].w * rstd * gj.w;
            o8[64 * j] = (unsigned long long)f2bf(v[j].x) | ((unsigned long long)f2bf(v[j].y) << 16) | ((unsigned long long)f2bf(v[j].z) << 32) | ((unsigned long long)f2bf(v[j].w) << 48);
        }
        if (wfg) {
            float a[4] = {0.f, 0.f, 0.f, 0.f};
#pragma unroll
            for (int j = 0; j < 4; ++j) {
                const int k = 256 * j + 4 * lane;
                const float hv[4] = {v[j].x, v[j].y, v[j].z, v[j].w};
#pragma unroll
                for (int i = 0; i < 4; ++i) {
                    const float4 w = *(const float4*)(wfg + (size_t)(k + i) * INW);
                    a[0] += hv[i] * w.x; a[1] += hv[i] * w.y; a[2] += hv[i] * w.z; a[3] += hv[i] * w.w;
                }
            }
#pragma unroll
            for (int c = 0; c < 4; ++c) a[c] = wave_sum(a[c]);
            if (lane == 0) *(float4*)(fgbuf + (size_t)r * 4) = make_float4(a[0], a[1], a[2], a[3]);
        }
        if (wr && r < MAIN) {
            float a[8];
#pragma unroll
            for (int e = 0; e < 8; ++e) a[e] = 0.f;
#pragma unroll
            for (int j = 0; j < 4; ++j) {
                const int k = 256 * j + 4 * lane;
                const float hv[4] = {v[j].x, v[j].y, v[j].z, v[j].w};
#pragma unroll
                for (int i = 0; i < 4; ++i) {
                    const float4 w0 = *(const float4*)(wr + (size_t)(k + i) * 8), w1 = *(const float4*)(wr + (size_t)(k + i) * 8 + 4);
                    a[0] += hv[i] * w0.x; a[1] += hv[i] * w0.y; a[2] += hv[i] * w0.z; a[3] += hv[i] * w0.w;
                    a[4] += hv[i] * w1.x; a[5] += hv[i] * w1.y; a[6] += hv[i] * w1.z; a[7] += hv[i] * w1.w;
                }
            }
#pragma unroll
            for (int e = 0; e < 8; ++e) a[e] = wave_sum(a[e]);
            int i1 = 0; float v1 = a[0];
#pragma unroll
            for (int e = 1; e < 8; ++e) if (a[e] > v1) { v1 = a[e]; i1 = e; }
            int i2 = -1; float v2 = -3.0e38f;
#pragma unroll
            for (int e = 0; e < 8; ++e) if (e != i1 && a[e] > v2) { v2 = a[e]; i2 = e; }
            const float g1 = 1.0f / (1.0f + expf(v2 - v1)), g2 = 1.0f - g1;
            if (lane < 8) gates[(size_t)r * 8 + lane] = lane == i1 ? g1 : (lane == i2 ? g2 : 0.f);
        }
    }
}

__device__ __forceinline__ float log_sigmoid(float x) { return fminf(x, 0.f) - log1pf(expf(-fabsf(x))); }
__global__ void k_cum(const float* __restrict__ fg, const float* __restrict__ bias, float* __restrict__ cum) {
    const int t = blockIdx.x * blockDim.x + threadIdx.x;
    if (t >= NB * 4) return;
    const int b = t >> 2, h = t & 3; const float bi = bias[h];
    float c = 0.f;
    for (int j = 0; j < NMETA; ++j) { c += log_sigmoid(fg[(size_t)(MAIN + j) * 4 + h] + bi); if (b == 0) cum[(size_t)(MAIN + j) * 4 + h] = c * LOG2E; }
    for (int t0 = 0; t0 < SEQ; t0 += 16) {
        float f[16];
#pragma unroll
        for (int i = 0; i < 16; ++i) f[i] = fg[(size_t)(b * SEQ + t0 + i) * 4 + h];
#pragma unroll
        for (int i = 0; i < 16; ++i) { c += log_sigmoid(f[i] + bi); cum[(size_t)(b * SEQ + t0 + i) * 4 + h] = c * LOG2E; }
    }
}

template <class Epi, bool DUAL>
__global__ __launch_bounds__(512) void k_gemm(const bf16_t* __restrict__ A, int lda, const float* __restrict__ W1, const float* __restrict__ W2, int ldw,
                                              int M, int N, int K, Epi epi) {
    __shared__ float As[16][132];
    __shared__ float B1s[16][132];
    __shared__ float B2s[DUAL ? 16 : 1][132];
    const int tid = threadIdx.x, tx = tid & 15, ty = tid >> 4;
    const int ntm = M / 128, ntn = N / 128;
    for (int tile = blockIdx.x; tile < ntm * ntn; tile += gridDim.x) {
        const int tm = tile / ntn, tn = tile % ntn, m0 = tm * 128, n0 = tn * 128;
        float acc1[4][8], acc2[4][8];
#pragma unroll
        for (int i = 0; i < 4; ++i)
#pragma unroll
            for (int j = 0; j < 8; ++j) { acc1[i][j] = 0.f; acc2[i][j] = 0.f; }
        for (int k0 = 0; k0 < K; k0 += 16) {
            {
                const int row = tid >> 2, kq = tid & 3;
                const uint2 av = *(const uint2*)(A + (size_t)(m0 + row) * lda + k0 + 4 * kq);
                As[4 * kq + 0][row] = __uint_as_float(av.x << 16); As[4 * kq + 1][row] = __uint_as_float(av.x & 0xffff0000u);
                As[4 * kq + 2][row] = __uint_as_float(av.y << 16); As[4 * kq + 3][row] = __uint_as_float(av.y & 0xffff0000u);
                const int kk = tid >> 5, nq = tid & 31;
                const float4 b1 = *(const float4*)(W1 + (size_t)(k0 + kk) * ldw + n0 + 4 * nq);
                *(float4*)&B1s[kk][4 * nq] = b1;
                if (DUAL) { const float4 b2 = *(const float4*)(W2 + (size_t)(k0 + kk) * ldw + n0 + 4 * nq); *(float4*)&B2s[kk][4 * nq] = b2; }
            }
            __syncthreads();
#pragma unroll
            for (int kk = 0; kk < 16; ++kk) {
                const float4 a4 = *(const float4*)&As[kk][ty * 4];
                const float a[4] = {a4.x, a4.y, a4.z, a4.w};
                const float4 b0 = *(const float4*)&B1s[kk][tx * 8], b1 = *(const float4*)&B1s[kk][tx * 8 + 4];
                const float b[8] = {b0.x, b0.y, b0.z, b0.w, b1.x, b1.y, b1.z, b1.w};
#pragma unroll
                for (int i = 0; i < 4; ++i)
#pragma unroll
                    for (int j = 0; j < 8; ++j) acc1[i][j] += a[i] * b[j];
                if (DUAL) {
                    const float4 c0 = *(const float4*)&B2s[kk][tx * 8], c1 = *(const float4*)&B2s[kk][tx * 8 + 4];
                    const float c[8] = {c0.x, c0.y, c0.z, c0.w, c1.x, c1.y, c1.z, c1.w};
#pragma unroll
                    for (int i = 0; i < 4; ++i)
#pragma unroll
                        for (int j = 0; j < 8; ++j) acc2[i][j] += a[i] * c[j];
                }
            }
            __syncthreads();
        }
#pragma unroll
        for (int i = 0; i < 4; ++i)
#pragma unroll
            for (int j = 0; j < 8; ++j) epi(m0 + ty * 4 + i, n0 + tx * 8 + j, acc1[i][j], acc2[i][j]);
    }
}
struct EpiZ { bf16_t* z; __device__ void operator()(int m, int n, float a, float) const {
    const float sc = ((n >= C_DQ && n < C_DK) || (n >= C_FQ && n < C_FK)) ? QSCALE : 1.0f; z[(size_t)m * ZW + n] = f2bf(a * sc); } };
struct EpiRes { RowSrc src; float* dout; float* resm; __device__ void operator()(int m, int n, float a, float) const {
    const float base = res_row(src, m)[n]; float* o = m < MAIN ? dout + (size_t)m * D : resm + (size_t)(m - MAIN) * D; o[n] = base + a; } };
struct EpiSwiglu { bf16_t* h; int ldh; int pad; __device__ void operator()(int m, int n, float a, float b) const { h[(size_t)m * ldh + n] = f2bf(a / (1.0f + expf(-a)) * b); } };
struct EpiGlu { bf16_t* mix; __device__ void operator()(int m, int n, float a, float b) const { mix[(size_t)m * D + n] = f2bf(a / (1.0f + expf(-b))); } };
struct EpiMoeDown { const float* gates; float* dout; int e; int pad; __device__ void operator()(int m, int n, float a, float) const { dout[(size_t)m * D + n] += gates[(size_t)m * 8 + e] * a; } };

__device__ __forceinline__ double exp_small(double x) {
    const double y = x * (1.0 / 1024.0); double t = 1.0, s = 1.0;
#pragma unroll
    for (int i = 1; i <= 10; ++i) { t = t * y / (double)i; s += t; }
#pragma unroll
    for (int i = 0; i < 10; ++i) s = s * s;
    return s;
}
__device__ __forceinline__ void sincos_d(double x, double& sn, double& cs) {
    const double TWO_PI = 6.283185307179586476925;
    const double k = rint(x / TWO_PI); const double r = x - k * TWO_PI, r2 = r * r;
    double ts = r, tc = 1.0; sn = r; cs = 1.0;
#pragma unroll
    for (int i = 1; i <= 15; ++i) { tc = -tc * r2 / (double)((2 * i - 1) * (2 * i)); cs += tc; ts = -ts * r2 / (double)((2 * i) * (2 * i + 1)); sn += ts; }
}
__device__ __forceinline__ void ssm_consts(const float* lam_re, const float* lam_im, const float* log_dt, int g, int n, float& are, float& aim, float& cre, float& cim) {
    const double dt = exp_small((double)log_dt[g]);
    const double lr = (double)lam_re[g * 64 + n], li = (double)lam_im[g * 64 + n];
    const double mag = exp_small(lr * dt); double sn, cs; sincos_d(li * dt, sn, cs);
    const double ar = mag * cs, ai = mag * sn, den = lr * lr + li * li, nr = ar - 1.0, ni = ai;
    are = (float)ar; aim = (float)ai; cre = (float)((nr * lr + ni * li) / den); cim = (float)((ni * lr - nr * li) / den);
}
__device__ __forceinline__ float gelu_tanh(float x) { return 0.5f * x * (1.0f + tanhf(0.7978845608028654f * (x + 0.044715f * x * x * x))); }
__global__ __launch_bounds__(64) void k_ssm_naive(const bf16_t* __restrict__ z, const float* lam_re, const float* lam_im, const float* log_dt,
                                                  const float* __restrict__ b_re, const float* __restrict__ b_im, const float* __restrict__ c_re, const float* __restrict__ c_im,
                                                  const float* __restrict__ dsk, bf16_t* __restrict__ ybuf) {
    __shared__ float2 xs[64];
    const int n = threadIdx.x, g = blockIdx.x & 15, b = blockIdx.x >> 4;
    float are, aim, cre, cim; ssm_consts(lam_re, lam_im, log_dt, g, n, are, aim, cre, cim);
    float br[16], bi[16];
#pragma unroll
    for (int c = 0; c < 16; ++c) { const float r = b_re[(g * 64 + n) * 16 + c], i = b_im[(g * 64 + n) * 16 + c]; br[c] = cre * r - cim * i; bi[c] = cre * i + cim * r; }
    float xr = 0.f, xi = 0.f;
    for (int s = 0; s < NMETA + SEQ; ++s) {
        const int row = s < NMETA ? MAIN + s : b * SEQ + (s - NMETA);
        const uint4 u0 = *(const uint4*)(z + (size_t)row * ZW + 16 * g), u1 = *(const uint4*)(z + (size_t)row * ZW + 16 * g + 8);
        const unsigned uw[8] = {u0.x, u0.y, u0.z, u0.w, u1.x, u1.y, u1.z, u1.w};
        float pr = 0.f, pi = 0.f;
#pragma unroll
        for (int c = 0; c < 8; ++c) { const float lo = __uint_as_float(uw[c] << 16), hi = __uint_as_float(uw[c] & 0xffff0000u);
            pr += lo * br[2 * c] + hi * br[2 * c + 1]; pi += lo * bi[2 * c] + hi * bi[2 * c + 1]; }
        const float nxr = are * xr - aim * xi + pr, nxi = are * xi + aim * xr + pi; xr = nxr; xi = nxi;
        xs[n] = make_float2(xr, xi);
        __syncthreads();
        if (n < 16 && (s >= NMETA || b == 0)) {
            const float* cr = c_re + (g * 16 + n) * 64; const float* ci = c_im + (g * 16 + n) * 64; float y = 0.f;
            for (int m = 0; m < 64; ++m) y += xs[m].x * cr[m] - xs[m].y * ci[m];
            y += dsk[g * 16 + n] * bf2f(z[(size_t)row * ZW + 16 * g + n]);
            ybuf[(size_t)row * 256 + 16 * g + n] = f2bf(gelu_tanh(y));
        }
        __syncthreads();
    }
}

__device__ __forceinline__ void attn_map(const bf16_t* __restrict__ z, const float* __restrict__ cum, int r, int b, int nk, int qcol, int kcol, int vcol, bool two_v, int bias_h,
                                         float* sc, int lane, float& o0, float& o1) {
    float q[64];
    {
        const uint4* qp = (const uint4*)(z + (size_t)r * ZW + qcol);
#pragma unroll
        for (int i = 0; i < 8; ++i) { const uint4 w = qp[i]; const unsigned ww[4] = {w.x, w.y, w.z, w.w};
#pragma unroll
            for (int j = 0; j < 4; ++j) { q[8 * i + 2 * j] = __uint_as_float(ww[j] << 16); q[8 * i + 2 * j + 1] = __uint_as_float(ww[j] & 0xffff0000u); } }
    }
    const float cq = bias_h >= 0 ? cum[(size_t)r * 4 + bias_h] : 0.f;
    float mx = -3.0e38f;
    for (int k = lane; k < nk; k += 64) {
        const int kr = k < NMETA ? MAIN + k : b * SEQ + (k - NMETA);
        const uint4* kp = (const uint4*)(z + (size_t)kr * ZW + kcol);
        float s = 0.f;
#pragma unroll
        for (int i = 0; i < 8; ++i) { const uint4 w = kp[i]; const unsigned ww[4] = {w.x, w.y, w.z, w.w};
#pragma unroll
            for (int j = 0; j < 4; ++j) s += q[8 * i + 2 * j] * __uint_as_float(ww[j] << 16) + q[8 * i + 2 * j + 1] * __uint_as_float(ww[j] & 0xffff0000u); }
        if (bias_h >= 0) s += cq - cum[(size_t)kr * 4 + bias_h];
        sc[k] = s; mx = fmaxf(mx, s);
    }
    mx = wave_max(mx);
    asm volatile("s_waitcnt lgkmcnt(0)" ::: "memory");
    float sum = 0.f;
    for (int k = lane; k < nk; k += 64) { const float p = exp2f(sc[k] - mx); sc[k] = p; sum += p; }
    sum = wave_sum(sum);
    asm volatile("s_waitcnt lgkmcnt(0)" ::: "memory");
    float a0 = 0.f, a1 = 0.f;
    for (int k = 0; k < nk; ++k) {
        const int kr = k < NMETA ? MAIN + k : b * SEQ + (k - NMETA);
        const float p = sc[k];
        a0 += p * bf2f(z[(size_t)kr * ZW + vcol + lane]);
        if (two_v) a1 += p * bf2f(z[(size_t)kr * ZW + vcol + 64 + lane]);
    }
    asm volatile("s_waitcnt lgkmcnt(0)" ::: "memory");
    const float inv = 1.0f / sum; o0 = a0 * inv; o1 = a1 * inv;
}
__global__ __launch_bounds__(256) void k_final(float* __restrict__ dout, const float* __restrict__ g) {
    const int lane = threadIdx.x & 63;
    const int gw = (blockIdx.x * blockDim.x + threadIdx.x) >> 6, nw = (gridDim.x * blockDim.x) >> 6;
    for (int r = gw; r < MAIN; r += nw) {
        float4* p = (float4*)(dout + (size_t)r * D) + lane;
        float4 v[4]; float ss = 0.f;
#pragma unroll
        for (int j = 0; j < 4; ++j) { v[j] = p[64 * j]; ss += v[j].x * v[j].x + v[j].y * v[j].y + v[j].z * v[j].z + v[j].w * v[j].w; }
        ss = wave_sum(ss);
        const float rstd = 1.0f / sqrtf(ss * (1.0f / D) + EPS);
#pragma unroll
        for (int j = 0; j < 4; ++j) { const float4 gj = ((const float4*)g)[lane + 64 * j];
            p[64 * j] = make_float4(v[j].x * rstd * gj.x, v[j].y * rstd * gj.y, v[j].z * rstd * gj.z, v[j].w * rstd * gj.w); }
    }
}

__global__ __launch_bounds__(256) void k_attn_naive_l(const bf16_t* __restrict__ z, const float* __restrict__ cum, const float* __restrict__ lamp, const float* __restrict__ subg, bf16_t* __restrict__ mix) {
    __shared__ float scs[4][2080];
    const int lane = threadIdx.x & 63, w = threadIdx.x >> 6;
    const int gw = blockIdx.x * 4 + w, nw = gridDim.x * 4;
    const float lam = lamp[0], oml = lamp[1];
    float* sc = scs[w];
    for (int item = gw; item < MVALID * 8; item += nw) {
        const int r = item >> 3, hv = item & 7;
        int b = 0, nk;
        if (r < MAIN) { b = r / SEQ; nk = NMETA + (r % SEQ) + 1; } else nk = (r - MAIN) + 1;
        if (hv < 4) {
            const int h = hv; float p0, p1, n0, n1;
            attn_map(z, cum, r, b, nk, C_DQ + 128 * h, C_DK + 128 * h, C_DV + 128 * h, true, -1, sc, lane, p0, p1);
            attn_map(z, cum, r, b, nk, C_DQ + 128 * h + 64, C_DK + 128 * h + 64, C_DV + 128 * h, true, -1, sc, lane, n0, n1);
            const float o0 = p0 - lam * n0, o1 = p1 - lam * n1;
            const float ss = wave_sum(o0 * o0 + o1 * o1);
            const float rstd = 1.0f / sqrtf(ss * (1.0f / 128.0f) + EPS);
            mix[(size_t)r * D + 256 + 128 * h + lane] = f2bf(o0 * rstd * subg[lane] * oml);
            mix[(size_t)r * D + 256 + 128 * h + 64 + lane] = f2bf(o1 * rstd * subg[64 + lane] * oml);
        } else {
            const int h = hv - 4; float o0, o1;
            attn_map(z, cum, r, b, nk, C_FQ + 64 * h, C_FK + 64 * h, C_FV + 64 * h, false, h, sc, lane, o0, o1);
            mix[(size_t)r * D + 768 + 64 * h + lane] = f2bf(o0);
        }
    }
}

#include <cstdio>
namespace pg8 {
#define PG8_LAS __attribute__((address_space(3)))
typedef unsigned short bf16_t;
typedef short bf16x8 __attribute__((ext_vector_type(8)));
typedef float f32x4 __attribute__((ext_vector_type(4)));
typedef unsigned u32x4 __attribute__((ext_vector_type(4)));
constexpr int BM = 256, BK = 64, HALF = 128, HTB = HALF * BK * 2  , STAGE_BYTES = 8 * HTB, NXCD = 8, WGM = 8;

__host__ __device__ __forceinline__ int lds_byte(int r, int c) { const int st = (r >> 4) * 2 + (c >> 5), rr = r & 15, cc = c & 31, ob = rr * 64 + cc * 2; return st * 1024 + (ob ^ (((ob >> 9) & 1) << 5)); }
__host__ __device__ __forceinline__ void stage_rc(int b, int& R, int& C) { const int st = b / 1024, sb = b % 1024, swz = sb ^ (((sb >> 9) & 1) << 5); R = (st >> 1) * 16 + swz / 64; C = (st & 1) * 32 + (swz % 64) / 2; }
__host__ __device__ __forceinline__ int perm32(int rho) { const int n = rho >> 4, i = rho & 15; return 8 * (i >> 2) + 4 * n + (i & 3); }

struct Unit { int pm, pn; };
struct Gemm { const bf16_t* A; const bf16_t* Bt; int M, N, K; };

struct StaticOrder {
    int nM, nN, nwg, G, c;
    __host__ __device__ void init(int M, int N, int G_, int c_) { nM = M / BM; nN = N / BM; nwg = nM * nN; G = G_; c = c_; }
    __host__ __device__ bool next(int i, Unit& u) const {
        const long L = (long)i * G + c; if (L >= nwg) return false;
        int wgid = (int)L; { const int q = nwg / NXCD, r = nwg % NXCD, xcd = wgid % NXCD, off = wgid / NXCD; wgid = (xcd < r ? xcd * (q + 1) : r * (q + 1) + (xcd - r) * q) + off; }
        const int nig = WGM * nN, gid = wgid / nig, fm = gid * WGM, gsz = (nM - fm) < WGM ? (nM - fm) : WGM;
        u.pm = fm + ((wgid % nig) % gsz); u.pn = (wgid % nig) / gsz; return true;
    }
    __device__ __forceinline__ void a_ready(const Unit&) const {}
    __device__ __forceinline__ void done(const Unit&) const {}
    static constexpr bool GATHER = false;
    __device__ __forceinline__ const char* a_ptr(const Gemm& g, const Unit& u) const { return (const char*)g.A + (size_t)u.pm * ((size_t)BM * g.K * 2); }
    __device__ __forceinline__ const char* b_ptr(const Gemm& g, const Unit& u) const { return (const char*)g.Bt + (size_t)u.pn * ((size_t)BM * g.K * 2); }
    __device__ __forceinline__ void gather_offs(const Gemm&, const Unit&, const int (&)[2], const int (&)[2], unsigned (&)[2][2]) const {}
};

__device__ __forceinline__ unsigned cvt_pk_bf16(float lo, float hi) { unsigned r; asm volatile("v_cvt_pk_bf16_f32 %0, %1, %2" : "=v"(r) : "v"(lo), "v"(hi)); return r; }
typedef float f32x2 __attribute__((ext_vector_type(2)));
__device__ __forceinline__ f32x2 gelu_pk(f32x2 v) {
    const f32x2 av = __builtin_elementwise_abs(v), d = av * 0.2316418882f + 1.0f;
    f32x2 t; t.x = __builtin_amdgcn_rcpf(d.x); t.y = __builtin_amdgcn_rcpf(d.y);
    f32x2 q = t * 0.5307027145f + (-0.7265760135f); q = q * t + 0.7107068705f; q = q * t + (-0.142248368f); q = q * t + 0.127414796f; q = q * t;
    const f32x2 s = (v * v) * (-0.72134752044f);
    f32x2 e; e.x = __builtin_amdgcn_exp2f(s.x); e.y = __builtin_amdgcn_exp2f(s.y);
    const f32x2 m = v * (q * e), r = v - m;
    f32x2 o; o.x = v.x < 0.f ? m.x : r.x; o.y = v.y < 0.f ? m.y : r.y; return o;
}

template <int ACT  > struct EpiBf16 {
    static constexpr bool PERM = true, AFTER_DRAIN = false; static_assert(ACT == 0 || ACT == 1, "EpiBf16: ACT is 0 (none) or 1 (gelu_pk)");
    bf16_t* O; int ldc; const float* bias; int split_cols; size_t split_stride; float scale0;
    __device__ __forceinline__ void operator()(const f32x4 (&acc)[2][2][4][2], const Unit& u, int wr, int wc, int fr, int fq) const {
        const int row0 = u.pm * BM + wr * 64 + fr; int colt = u.pn * BM; bf16_t* base = O;
        float sc = 1.f; if (split_cols) { const int t = colt / split_cols; base += (size_t)t * split_stride; colt -= t * split_cols; if (t == 0) sc = scale0; }
        const int col0 = colt + wc * 32 + 8 * fq, bcol0 = u.pn * BM + wc * 32 + 8 * fq;
        f32x4 bv[2][2];
#pragma unroll
        for (int bj = 0; bj < 2; ++bj)
#pragma unroll
            for (int n = 0; n < 2; ++n) bv[bj][n] = bias ? *(const f32x4*)(bias + bcol0 + bj * HALF + 4 * n) : (f32x4){0.f, 0.f, 0.f, 0.f};
#pragma unroll
        for (int ai = 0; ai < 2; ++ai)
#pragma unroll
            for (int m = 0; m < 4; ++m) { bf16_t* rowp = base + (size_t)(row0 + ai * HALF + m * 16) * ldc + col0;
#pragma unroll
                for (int bj = 0; bj < 2; ++bj) { f32x4 v0 = acc[ai][bj][m][0] + bv[bj][0], v1 = acc[ai][bj][m][1] + bv[bj][1];
                    if (ACT == 1) { f32x2 a = gelu_pk((f32x2){v0[0], v0[1]}), b = gelu_pk((f32x2){v0[2], v0[3]}), c = gelu_pk((f32x2){v1[0], v1[1]}), d = gelu_pk((f32x2){v1[2], v1[3]});
                        v0 = (f32x4){a.x, a.y, b.x, b.y}; v1 = (f32x4){c.x, c.y, d.x, d.y}; }
                    v0 = v0 * sc; v1 = v1 * sc; u32x4 w; w.x = cvt_pk_bf16(v0[0], v0[1]); w.y = cvt_pk_bf16(v0[2], v0[3]); w.z = cvt_pk_bf16(v1[0], v1[1]); w.w = cvt_pk_bf16(v1[2], v1[3]);
                    *(u32x4*)(rowp + bj * HALF) = w; } }
    }
};

struct PanelStats {
    unsigned* xbuf;
    unsigned* cnt;
    unsigned* tmo;
    int ntn; float eps;
    unsigned code;
    __device__ __forceinline__ bool run(const f32x4 (&v)[2][2][4][2], const Unit& u, int wr, int wc, int fr, int fq, PG8_LAS unsigned char* lds, int wid, int lane) const {
        typedef float f32x2v __attribute__((ext_vector_type(2)));
        PG8_LAS f32x2v* P = (PG8_LAS f32x2v*)lds;
        PG8_LAS f32x2v* S = (PG8_LAS f32x2v*)(lds + 8192);
        PG8_LAS unsigned* flag = (PG8_LAS unsigned*)(lds + 8192 + 2048);
#pragma unroll
        for (int ai = 0; ai < 2; ++ai)
#pragma unroll
            for (int m = 0; m < 4; ++m) {
                float s = 0.f;
#pragma unroll
                for (int bj = 0; bj < 2; ++bj)
#pragma unroll
                    for (int n = 0; n < 2; ++n) { const f32x4 x = v[ai][bj][m][n]; s += (x[0] + x[1]) + (x[2] + x[3]); }
                s += __shfl_xor(s, 16); s += __shfl_xor(s, 32);
                const float mw = s * (1.0f / 64.0f); float q = 0.f;
#pragma unroll
                for (int bj = 0; bj < 2; ++bj)
#pragma unroll
                    for (int n = 0; n < 2; ++n) { const f32x4 d = v[ai][bj][m][n] - mw; q += (d[0] * d[0] + d[1] * d[1]) + (d[2] * d[2] + d[3] * d[3]); }
                q += __shfl_xor(q, 16); q += __shfl_xor(q, 32);
                if (fq == 0) P[(ai * HALF + wr * 64 + m * 16 + fr) * 4 + wc] = (f32x2v){mw, q};
            }
        asm volatile("s_waitcnt lgkmcnt(0)" ::: "memory"); __builtin_amdgcn_s_barrier(); asm volatile("" ::: "memory");
#if defined(BROKEN_EXCHANGE_NO_WAIT)
#warning BROKEN CONTROL BUILD: the row-statistics exchange does not wait; results are wrong by design
        if (blockIdx.x >= 64) { const long long t0_ = clock64(); while (clock64() - t0_ < 60000) __builtin_amdgcn_s_sleep(8); }
#endif
        const int row = wid * 32 + (lane & 31);
        if (lane < 32) {
            const f32x2v a = P[row * 4 + 0], b = P[row * 4 + 1], c = P[row * 4 + 2], d = P[row * 4 + 3];
            const float mt = (a.x + b.x + c.x + d.x) * 0.25f;
            const float da = a.x - mt, db = b.x - mt, dc = c.x - mt, dd = d.x - mt;
            const float m2 = (a.y + b.y) + (c.y + d.y) + 64.0f * ((da * da + db * db) + (dc * dc + dd * dd));
            unsigned long long* slot = (unsigned long long*)xbuf + ((size_t)(u.pm * BM + row) * 4 + u.pn);
            __hip_atomic_store(slot, ((unsigned long long)__float_as_uint(m2) << 32) | __float_as_uint(mt), __ATOMIC_RELAXED, __HIP_MEMORY_SCOPE_AGENT);
        }
        asm volatile("s_waitcnt vmcnt(0)" ::: "memory");
        if (lane == 0) __hip_atomic_fetch_add(cnt + 64 * u.pm, 1u, __ATOMIC_RELAXED, __HIP_MEMORY_SCOPE_AGENT);
        if (wid == 0) {
            bool dead = false; const unsigned long long t0 = __builtin_amdgcn_s_memrealtime(); const unsigned want = 8u * (unsigned)ntn;
            for (;;) {
#if defined(BROKEN_EXCHANGE_NO_WAIT)
                break;
#endif
                if ((unsigned)__builtin_amdgcn_readfirstlane(__hip_atomic_load(cnt + 64 * u.pm, __ATOMIC_RELAXED, __HIP_MEMORY_SCOPE_AGENT)) >= want) break;
                if (__builtin_amdgcn_s_memrealtime() - t0 > 2000000ull) {
                    if (lane == 0) { unsigned expect = 0u; __hip_atomic_compare_exchange_strong(tmo + 1, &expect, code | (unsigned)(u.pm & 0xff), __ATOMIC_RELAXED, __ATOMIC_RELAXED, __HIP_MEMORY_SCOPE_AGENT);
                                     __hip_atomic_store(tmo, 1u, __ATOMIC_RELAXED, __HIP_MEMORY_SCOPE_AGENT); }
                    dead = true; break; }
                __builtin_amdgcn_s_sleep(2);
            }
            __builtin_amdgcn_fence(__ATOMIC_ACQUIRE, "agent");
            if (lane == 0) flag[0] = dead ? 1u : 0u;
        }
        asm volatile("s_waitcnt vmcnt(0) lgkmcnt(0)" ::: "memory"); __builtin_amdgcn_s_barrier(); asm volatile("" ::: "memory");
        const bool bad = flag[0] != 0u;
        if (lane < 32) {
            const unsigned long long* slot = (const unsigned long long*)xbuf + (size_t)(u.pm * BM + row) * 4; float mt[4], m2[4]; float ms = 0.f;
#pragma unroll
            for (int t = 0; t < 4; ++t) { if (t < ntn) { const unsigned long long w = __hip_atomic_load(slot + t, __ATOMIC_RELAXED, __HIP_MEMORY_SCOPE_AGENT); mt[t] = __uint_as_float((unsigned)w); m2[t] = __uint_as_float((unsigned)(w >> 32)); } else { mt[t] = 0.f; m2[t] = 0.f; } ms += mt[t]; }
            const float mean = ms / (float)ntn; float q = 0.f;
#pragma unroll
            for (int t = 0; t < 4; ++t) if (t < ntn) { const float dm = mt[t] - mean; q += m2[t] + 256.0f * dm * dm; }
            S[row] = (f32x2v){mean, 1.0f / sqrtf(q / (256.0f * (float)ntn) + eps)};
        }
        asm volatile("s_waitcnt lgkmcnt(0)" ::: "memory"); __builtin_amdgcn_s_barrier(); asm volatile("" ::: "memory");
        return bad;
    }
};
struct EpiLnRes {
    static constexpr bool PERM = false, AFTER_DRAIN = true;
    const float* base; float* out; int ldc; const float* bias; PanelStats st; unsigned poison;
    __device__ __forceinline__ void fused(f32x4 (&acc)[2][2][4][2], const Unit& u, int wr, int wc, int fr, int fq, PG8_LAS unsigned char* lds, int wid, int lane) const {
        typedef float f32x2v __attribute__((ext_vector_type(2)));
        const PG8_LAS f32x2v* S = (const PG8_LAS f32x2v*)(lds + 8192);
        const int col0 = u.pn * BM + wc * 32 + 4 * fq;
#pragma unroll
        for (int bj = 0; bj < 2; ++bj)
#pragma unroll
            for (int n = 0; n < 2; ++n) { const f32x4 bv = bias ? *(const f32x4*)(bias + col0 + bj * HALF + n * 16) : (f32x4){0.f, 0.f, 0.f, 0.f};
#pragma unroll
                for (int ai = 0; ai < 2; ++ai)
#pragma unroll
                    for (int m = 0; m < 4; ++m) acc[ai][bj][m][n] += bv; }
        f32x4 pre[4][2][2];
#pragma unroll
        for (int m = 0; m < 4; ++m) { const size_t off = (size_t)(u.pm * BM + wr * 64 + m * 16 + fr) * ldc + col0;
#pragma unroll
            for (int bj = 0; bj < 2; ++bj)
#pragma unroll
                for (int n = 0; n < 2; ++n) pre[m][bj][n] = *(const f32x4*)(base + off + bj * HALF + n * 16); }
        const bool bad = st.run(acc, u, wr, wc, fr, fq, lds, wid, lane) || poison != 0u;
        const float qnan = __builtin_nanf("");
#pragma unroll
        for (int ai = 0; ai < 2; ++ai)
#pragma unroll
            for (int m = 0; m < 4; ++m) { const int r = ai * HALF + wr * 64 + m * 16 + fr; const f32x2v sr = S[r]; const size_t off = (size_t)(u.pm * BM + r) * ldc + col0;
#pragma unroll
                for (int bj = 0; bj < 2; ++bj)
#pragma unroll
                    for (int n = 0; n < 2; ++n) { const f32x4 bs = ai == 0 ? pre[m][bj][n] : *(const f32x4*)(base + off + bj * HALF + n * 16); f32x4 o = bs + (acc[ai][bj][m][n] - sr.x) * sr.y;
                        if (bad) o = (f32x4){qnan, qnan, qnan, qnan}; *(f32x4*)(out + off + bj * HALF + n * 16) = o; }
                if (m & 1) asm volatile("" ::: "memory"); }
    }
};
struct EpiLnResLn {
    static constexpr bool PERM = false, AFTER_DRAIN = true;
    const float* base; float* out; bf16_t* xn; int ldc; const float* bias; PanelStats st1, st2; unsigned poison;
    __device__ __forceinline__ void fused(f32x4 (&acc)[2][2][4][2], const Unit& u, int wr, int wc, int fr, int fq, PG8_LAS unsigned char* lds, int wid, int lane) const {
        typedef float f32x2v __attribute__((ext_vector_type(2))); typedef unsigned u32x2v __attribute__((ext_vector_type(2)));
        const PG8_LAS f32x2v* S = (const PG8_LAS f32x2v*)(lds + 8192);
        const int col0 = u.pn * BM + wc * 32 + 4 * fq;
#pragma unroll
        for (int bj = 0; bj < 2; ++bj)
#pragma unroll
            for (int n = 0; n < 2; ++n) { const f32x4 bv = bias ? *(const f32x4*)(bias + col0 + bj * HALF + n * 16) : (f32x4){0.f, 0.f, 0.f, 0.f};
#pragma unroll
                for (int ai = 0; ai < 2; ++ai)
#pragma unroll
                    for (int m = 0; m < 4; ++m) acc[ai][bj][m][n] += bv; }
        bool bad = st1.run(acc, u, wr, wc, fr, fq, lds, wid, lane) || poison != 0u;
        const float qnan = __builtin_nanf("");
#pragma unroll
        for (int ai = 0; ai < 2; ++ai)
#pragma unroll
            for (int m = 0; m < 4; ++m) { const int r = ai * HALF + wr * 64 + m * 16 + fr; const f32x2v sr = S[r]; const size_t off = (size_t)(u.pm * BM + r) * ldc + col0;
#pragma unroll
                for (int bj = 0; bj < 2; ++bj)
#pragma unroll
                    for (int n = 0; n < 2; ++n) { const f32x4 bs = *(const f32x4*)(base + off + bj * HALF + n * 16); acc[ai][bj][m][n] = bs + (acc[ai][bj][m][n] - sr.x) * sr.y; }
                asm volatile("" : "+v"(acc[ai][0][m][0]), "+v"(acc[ai][0][m][1]), "+v"(acc[ai][1][m][0]), "+v"(acc[ai][1][m][1]));
                if (m & 1) asm volatile("" ::: "memory"); }
        const bool bad1 = bad;
        bad = st2.run(acc, u, wr, wc, fr, fq, lds, wid, lane) || bad;
#pragma unroll
        for (int ai = 0; ai < 2; ++ai)
#pragma unroll
            for (int m = 0; m < 4; ++m) { const int r = ai * HALF + wr * 64 + m * 16 + fr; const f32x2v sr = S[r]; const size_t off = (size_t)(u.pm * BM + r) * ldc + col0;
#pragma unroll
                for (int bj = 0; bj < 2; ++bj)
#pragma unroll
                    for (int n = 0; n < 2; ++n) { const f32x4 x1 = acc[ai][bj][m][n]; *(f32x4*)(out + off + bj * HALF + n * 16) = bad1 ? (f32x4){qnan, qnan, qnan, qnan} : x1;
                        const f32x4 o = (x1 - sr.x) * sr.y; u32x2v w; w.x = cvt_pk_bf16(o[0], o[1]); w.y = cvt_pk_bf16(o[2], o[3]);
                        if (bad) { w.x = 0x7fc07fc0u; w.y = 0x7fc07fc0u; } *(u32x2v*)(xn + off + bj * HALF + n * 16) = w; }
                asm volatile("" ::: "memory"); }
    }
};

template <class Epi, class Sched, bool ALIGN_EPI = false, bool SP2 = false>
__device__ __forceinline__ void gemm_phase(PG8_LAS unsigned char* lds, const Gemm g, const Sched& S, const Epi& E) {
    int tid_ = threadIdx.x; asm volatile("" : "+v"(tid_));
    const int tid = tid_, wid = __builtin_amdgcn_readfirstlane(tid >> 6), lane = tid & 63, wr = wid >> 2, wc = wid & 3, fr = lane & 15, fq = lane >> 4;
    const int K = g.K, nt = K / BK;
    unsigned voffA[2], voffB[2]; int stR[2], stC[2]; unsigned voC[2][2] = {{0u, 0u}, {0u, 0u}}, voN[2][2] = {{0u, 0u}, {0u, 0u}};
#pragma unroll
    for (int i = 0; i < 2; ++i) { int R, C; stage_rc(tid * 16 + i * 8192, R, C); const int Rb = Epi::PERM ? ((R & ~31) + perm32(R & 31)) : R;
        voffA[i] = (unsigned)(R * K + C) * 2u; voffB[i] = (unsigned)(Rb * K + C) * 2u; stR[i] = R; stC[i] = C; }
    const size_t kstep = (size_t)(BK * 2);
    const size_t hstep = (size_t)HALF * K * 2;
    const size_t tstep = 2 * hstep;
    const unsigned ldsw = (unsigned)wid * 1024u;
    const int aoff = lds_byte(wr * 64 + fr, fq * 8), boff = lds_byte(wc * 32 + fr, fq * 8);
#define PG8_SA(b, h) (((b) * 2 + (h)) * HTB)
#define PG8_SB(b, h) ((4 + (b) * 2 + (h)) * HTB)
#define PG8_STAGE(bufoff, gbase, voff) do { _Pragma("unroll") for (int _i = 0; _i < 2; ++_i) \
        __builtin_amdgcn_global_load_lds((const unsigned*)((const char*)(gbase) + (voff)[_i]), (PG8_LAS unsigned*)(lds + (bufoff) + ldsw + _i * 8192), 16, 0, 0); } while (0)
#define PG8_STAGE_A(bufoff, gbase, h, nx) do { if constexpr (Sched::GATHER) { _Pragma("unroll") for (int _i = 0; _i < 2; ++_i) { const unsigned _o = (nx) ? voN[h][_i] : voC[h][_i]; \
        __builtin_amdgcn_global_load_lds((const unsigned*)((const char*)(gbase) + _o), (PG8_LAS unsigned*)(lds + (bufoff) + ldsw + _i * 8192), 16, 0, 0); } } \
        else { PG8_STAGE(bufoff, (gbase) + (size_t)(h) * hstep, voffA); } } while (0)
#define PG8_LDA(dst, b, h) do { _Pragma("unroll") for (int m = 0; m < 4; ++m) _Pragma("unroll") for (int k = 0; k < 2; ++k) dst[m][k] = *(const PG8_LAS bf16x8*)(lds + PG8_SA(b, h) + aoff + m * 2048 + k * 1024); } while (0)
#define PG8_LDB(dst, b, h) do { _Pragma("unroll") for (int n = 0; n < 2; ++n) _Pragma("unroll") for (int k = 0; k < 2; ++k) dst[n][k] = *(const PG8_LAS bf16x8*)(lds + PG8_SB(b, h) + boff + n * 2048 + k * 1024); } while (0)
#define PG8_MMA(ai, bj, At, Bt) do { __builtin_amdgcn_s_setprio(1); _Pragma("unroll") for (int m = 0; m < 4; ++m) _Pragma("unroll") for (int n = 0; n < 2; ++n) _Pragma("unroll") for (int k = 0; k < 2; ++k) \
        acc[ai][bj][m][n] = __builtin_amdgcn_mfma_f32_16x16x32_bf16(Bt[n][k], At[m][k], acc[ai][bj][m][n], 0, 0, 0); __builtin_amdgcn_s_setprio(0); } while (0)
#define PG8_WAIT_V(n) asm volatile("s_waitcnt vmcnt(" #n ")" ::: "memory")
#define PG8_WAIT_L(n) asm volatile("s_waitcnt lgkmcnt(" #n ")" ::: "memory")
#define PG8_BAR __builtin_amdgcn_s_barrier()
#define PG8_SCHED __builtin_amdgcn_sched_barrier(0)
    Unit cur, nxt; int ui = 0;
    if (!S.next(0, cur)) return;
    f32x4 acc[2][2][4][2];
#pragma unroll
    for (int a = 0; a < 2; ++a)
#pragma unroll
        for (int b = 0; b < 2; ++b)
#pragma unroll
            for (int m = 0; m < 4; ++m)
#pragma unroll
                for (int n = 0; n < 2; ++n) acc[a][b][m][n] = (f32x4){0.f, 0.f, 0.f, 0.f};
    bf16x8 At[4][2], B0[2][2], B1[2][2];
    const char* cA = S.a_ptr(g, cur); const char* cB = S.b_ptr(g, cur);
    if constexpr (Sched::GATHER) S.gather_offs(g, cur, stR, stC, voC);
    S.a_ready(cur);
    if constexpr (SP2) {
        PG8_STAGE(PG8_SB(0, 0), cB, voffB); PG8_STAGE(PG8_SB(0, 1), cB + hstep, voffB); PG8_STAGE_A(PG8_SA(0, 0), cA, 0, false); PG8_STAGE_A(PG8_SA(0, 1), cA, 1, false);
        if (wr == 1) PG8_BAR;
        PG8_WAIT_V(2); PG8_BAR;
        PG8_STAGE(PG8_SB(1, 0), cB + kstep, voffB); PG8_STAGE_A(PG8_SA(1, 0), cA + kstep, 0, false); PG8_STAGE(PG8_SB(1, 1), cB + hstep + kstep, voffB);
        PG8_WAIT_V(6); PG8_BAR;
    } else {
        PG8_STAGE(PG8_SB(0, 0), cB, voffB); PG8_STAGE_A(PG8_SA(0, 0), cA, 0, false); PG8_STAGE(PG8_SB(0, 1), cB + hstep, voffB); PG8_STAGE_A(PG8_SA(0, 1), cA, 1, false);
        if (wr == 1) PG8_BAR;
        PG8_WAIT_V(4); PG8_BAR;
        PG8_STAGE(PG8_SB(1, 0), cB + kstep, voffB); PG8_STAGE_A(PG8_SA(1, 0), cA + kstep, 0, false); PG8_STAGE(PG8_SB(1, 1), cB + hstep + kstep, voffB);
        PG8_WAIT_V(6); PG8_BAR;
    }
    for (;;) {
        const bool has_next = S.next(ui + 1, nxt);
        const char* nA = has_next ? S.a_ptr(g, nxt) : cA; const char* nB = has_next ? S.b_ptr(g, nxt) : cB;
        if constexpr (Sched::GATHER) { if (has_next) S.gather_offs(g, nxt, stR, stC, voN); }
        for (int t = 0; t < nt; t += 2) {
            const bool last = (t == nt - 2); const bool nx = last && has_next; (void)nx;
            const char* a1 = cA + (size_t)(t + 1) * kstep;
            const char* a2 = last ? nA : cA + (size_t)(t + 2) * kstep; const char* b2 = last ? nB : cB + (size_t)(t + 2) * kstep;
            const char* a3 = a2 + kstep; const char* b3 = b2 + kstep;
            if (last && has_next) S.a_ready(nxt);
            if constexpr (SP2) {
            PG8_LDB(B0, 0, 0); PG8_LDB(B1, 0, 1); PG8_SCHED; PG8_LDA(At, 0, 0); PG8_STAGE_A(PG8_SA(1, 1), a1, 1, false);
            PG8_WAIT_V(8); PG8_WAIT_L(0); PG8_BAR; PG8_MMA(0, 0, At, B0); PG8_MMA(0, 1, At, B1); PG8_BAR; PG8_SCHED;
            PG8_LDA(At, 0, 1); PG8_STAGE(PG8_SB(0, 0), b2, voffB); PG8_STAGE(PG8_SB(0, 1), b2 + hstep, voffB); PG8_STAGE_A(PG8_SA(0, 0), a2, 0, nx);
            PG8_WAIT_V(8); PG8_WAIT_L(0); PG8_BAR; PG8_MMA(1, 0, At, B0); PG8_MMA(1, 1, At, B1); PG8_BAR; PG8_SCHED;
            PG8_LDB(B0, 1, 0); PG8_LDB(B1, 1, 1); PG8_SCHED; PG8_LDA(At, 1, 0); PG8_STAGE_A(PG8_SA(0, 1), a2, 1, nx);
            PG8_WAIT_V(8); PG8_WAIT_L(0); PG8_BAR; PG8_MMA(0, 0, At, B0); PG8_MMA(0, 1, At, B1); PG8_BAR; PG8_SCHED;
            PG8_LDA(At, 1, 1); PG8_STAGE(PG8_SB(1, 0), b3, voffB); PG8_STAGE(PG8_SB(1, 1), b3 + hstep, voffB); PG8_STAGE_A(PG8_SA(1, 0), a3, 0, nx);
            PG8_WAIT_V(8); PG8_WAIT_L(0); PG8_BAR; PG8_MMA(1, 0, At, B0); PG8_MMA(1, 1, At, B1); PG8_BAR; PG8_SCHED;
            } else {
            PG8_LDB(B0, 0, 0); PG8_SCHED; PG8_LDA(At, 0, 0); PG8_STAGE_A(PG8_SA(1, 1), a1, 1, false);
            PG8_WAIT_L(8); PG8_BAR; PG8_WAIT_L(0); PG8_MMA(0, 0, At, B0); PG8_BAR; PG8_SCHED;
            PG8_LDB(B1, 0, 1); PG8_STAGE(PG8_SB(0, 0), b2, voffB);
            PG8_BAR; PG8_WAIT_L(0); PG8_MMA(0, 1, At, B1); PG8_BAR;
            PG8_LDA(At, 0, 1); PG8_STAGE_A(PG8_SA(0, 0), a2, 0, nx);
            PG8_BAR; PG8_WAIT_L(0); PG8_MMA(1, 0, At, B0); PG8_BAR; PG8_SCHED;
            PG8_STAGE(PG8_SB(0, 1), b2 + hstep, voffB);
            PG8_WAIT_V(6); PG8_BAR; PG8_MMA(1, 1, At, B1); PG8_BAR;
            PG8_LDB(B0, 1, 0); PG8_SCHED; PG8_LDA(At, 1, 0); PG8_STAGE_A(PG8_SA(0, 1), a2, 1, nx);
            PG8_WAIT_L(8); PG8_BAR; PG8_WAIT_L(0); PG8_MMA(0, 0, At, B0); PG8_BAR; PG8_SCHED;
            PG8_LDB(B1, 1, 1); PG8_STAGE(PG8_SB(1, 0), b3, voffB);
            PG8_BAR; PG8_WAIT_L(0); PG8_MMA(0, 1, At, B1); PG8_BAR;
            PG8_LDA(At, 1, 1); PG8_STAGE_A(PG8_SA(1, 0), a3, 0, nx);
            PG8_BAR; PG8_WAIT_L(0); PG8_MMA(1, 0, At, B0); PG8_BAR; PG8_SCHED;
            PG8_STAGE(PG8_SB(1, 1), b3 + hstep, voffB);
            PG8_WAIT_V(6); PG8_BAR; PG8_MMA(1, 1, At, B1); PG8_BAR;
            }
        }
        if constexpr (ALIGN_EPI) { if (wr == 0) PG8_BAR; }
        if constexpr (!Epi::AFTER_DRAIN) { E(acc, cur, wr, wc, fr, fq); S.done(cur); }
        if (!has_next) break;
#pragma unroll
        for (int a = 0; a < 2; ++a)
#pragma unroll
            for (int b = 0; b < 2; ++b)
#pragma unroll
                for (int m = 0; m < 4; ++m)
#pragma unroll
                    for (int n = 0; n < 2; ++n) acc[a][b][m][n] = (f32x4){0.f, 0.f, 0.f, 0.f};
        cur = nxt; cA = nA; cB = nB; ++ui;
        if constexpr (Sched::GATHER) { voC[0][0] = voN[0][0]; voC[0][1] = voN[0][1]; voC[1][0] = voN[1][0]; voC[1][1] = voN[1][1]; }
        if constexpr (ALIGN_EPI) { if (wr == 1) PG8_BAR; }
    }
    PG8_WAIT_V(0);
    if constexpr (!ALIGN_EPI) { if (wr == 0) PG8_BAR; }
    PG8_BAR;
    if constexpr (Epi::AFTER_DRAIN) { E.fused(acc, cur, wr, wc, fr, fq, lds, wid, lane); S.done(cur); }
#undef PG8_SA
#undef PG8_SB
#undef PG8_STAGE
#undef PG8_STAGE_A
#undef PG8_LDA
#undef PG8_LDB
#undef PG8_MMA
#undef PG8_WAIT_V
#undef PG8_WAIT_L
#undef PG8_BAR
#undef PG8_SCHED
}
}

#define GAS __attribute__((address_space(1)))
#define LAS __attribute__((address_space(3)))
typedef unsigned v4u __attribute__((ext_vector_type(4)));
typedef float f32x4 __attribute__((ext_vector_type(4)));
typedef short bf16x8 __attribute__((ext_vector_type(8)));
typedef GAS unsigned gu32;
typedef GAS unsigned long long gu64;
#define RLX_AGENT __ATOMIC_RELAXED, __HIP_MEMORY_SCOPE_AGENT
#define LDS_WAIT() asm volatile("s_waitcnt lgkmcnt(0)" ::: "memory")
#define VM_WAIT() asm volatile("s_waitcnt vmcnt(0)" ::: "memory")
__device__ __forceinline__ unsigned long long rt() { return __builtin_amdgcn_s_memrealtime(); }
__device__ __forceinline__ unsigned f2bf_u(float f) { unsigned u = __builtin_bit_cast(unsigned, f); return (u + 0x7fffu + ((u >> 16) & 1u)) >> 16; }
__device__ __forceinline__ unsigned pk2(float lo, float hi) { return f2bf_u(lo) | (f2bf_u(hi) << 16); }

#define XB_TMO      128
#define XB_XCNT(j)  (256  + 64 * (j))
#define XB_XSUB(j)  (1280 + 64 * (j))
#define XB_XGEN(j)  (2304 + 64 * (j))
#define XB_TOP      3328
#define XB_TOPGEN   3392
#define XCD_BAR_WORDS 3456
#define XB_SPIN_CAP (1u << 18)

__device__ __forceinline__ unsigned xb_ld(unsigned* p)              { return __hip_atomic_load(p, __ATOMIC_RELAXED, __HIP_MEMORY_SCOPE_AGENT); }
__device__ __forceinline__ unsigned xb_add(unsigned* p, unsigned v) { return __hip_atomic_fetch_add(p, v, __ATOMIC_RELAXED, __HIP_MEMORY_SCOPE_AGENT); }
__device__ __forceinline__ unsigned xb_xcc_id() { return (unsigned)__builtin_amdgcn_s_getreg((3 << 11) | 20) & 0xFu; }
#define XB_SPIN(cond, bar) do { unsigned _sp = 0; while (cond) { __builtin_amdgcn_s_sleep(1); \
    if ((++_sp & 255u) == 0u) { if (xb_ld(&(bar)[XB_TMO])) break; if (_sp > XB_SPIN_CAP) { atomicAdd(&(bar)[XB_TMO], 1u); break; } } } } while (0)

struct XcdBarrier {
    unsigned* bar; unsigned x;
    volatile LAS unsigned* st;
};

__device__ __forceinline__ XcdBarrier xcd_barrier_post(unsigned* bar, volatile LAS unsigned* st) {
    XcdBarrier b; b.bar = bar; b.x = xb_xcc_id(); b.st = st;
    if (threadIdx.x == 0) (void)xb_add(&bar[XB_XCNT(b.x)], 1u);
    return b;
}
__device__ __forceinline__ void xcd_barrier_complete(unsigned* bar, unsigned x, unsigned& nloc, unsigned& nx) {
    const unsigned G = gridDim.x * gridDim.y * gridDim.z;
    unsigned sum, cnt, mine, sp = 0u;
    for (;;) {
        sum = 0u; cnt = 0u; mine = 0u;
#pragma unroll
        for (unsigned j = 0; j < 16; ++j) { const unsigned c = xb_ld(&bar[XB_XCNT(j)]); sum += c; cnt += (c > 0u) ? 1u : 0u; mine = (j == x) ? c : mine; }
        if (sum == G) break;
        __builtin_amdgcn_s_sleep(1);
        if ((++sp & 255u) == 0u) { if (xb_ld(&bar[XB_TMO])) break; if (sp > XB_SPIN_CAP) { atomicAdd(&bar[XB_TMO], 1u); break; } }
    }
    nloc = mine > 0u ? mine : 1u; nx = cnt > 0u ? cnt : 1u;
}

__device__ __forceinline__ void xcd_barrier(const XcdBarrier& b) {
    asm volatile("s_waitcnt vmcnt(0)" ::: "memory");
    __syncthreads();
    if (threadIdx.x == 0) {
        unsigned* bar = b.bar;
        __builtin_amdgcn_s_waitcnt(0);
        unsigned nloc = b.st[0], nx = b.st[1];
        if (nloc == 0u) { xcd_barrier_complete(bar, b.x, nloc, nx); b.st[0] = nloc; b.st[1] = nx; }
        const unsigned old = xb_add(&bar[XB_XSUB(b.x)], 1u);
        const unsigned gen = old / nloc;
        if (old + 1u == (gen + 1u) * nloc) {
            __builtin_amdgcn_fence(__ATOMIC_RELEASE, "agent");
            asm volatile("s_waitcnt vmcnt(0)" ::: "memory");
            const unsigned og = xb_add(&bar[XB_TOP], 1u);
            const unsigned tg = og / nx;
            if (og + 1u == (tg + 1u) * nx) xb_add(&bar[XB_TOPGEN], 1u);
            else XB_SPIN(xb_ld(&bar[XB_TOPGEN]) == tg, bar);
            __builtin_amdgcn_fence(__ATOMIC_ACQUIRE, "agent");
            xb_add(&bar[XB_XGEN(b.x)], 1u);
            asm volatile("s_waitcnt vmcnt(0)" ::: "memory");
        } else {
            XB_SPIN(xb_ld(&bar[XB_XGEN(b.x)]) == gen, bar);
            __builtin_amdgcn_fence(__ATOMIC_ACQUIRE, "agent");
            asm volatile("s_waitcnt vmcnt(0)" ::: "memory");
        }
    }
    __syncthreads();
}

constexpr int NWAVES = 8;
constexpr int LDS_BYTES = 147456;
constexpr int LDSCTL_OFF = 143360;
constexpr int MISC_OFF = LDSCTL_OFF + 320;

constexpr size_t W_CTL = 0, CTL_ZERO_BYTES = 1 * MiB;
constexpr size_t W_TAB = 1 * MiB;
constexpr size_t W_WE13 = 4 * MiB, W_WE2 = 116 * MiB, W_H = 172 * MiB, W_RESM = 205 * MiB, W_FG = 206 * MiB, W_CUM = 207 * MiB, W_TOK = 208 * MiB, W_LIST = 209 * MiB;
constexpr size_t W_WIN = 210 * MiB, W_WOUT = 220 * MiB, W_WGLU = 224 * MiB, W_W13 = 225 * MiB, W_W2 = 236 * MiB, W_Z = 242 * MiB, W_MIX = 324 * MiB, W_HD = 357 * MiB;
constexpr size_t W_HM = 210 * MiB;
constexpr size_t W_YM = 4 * MiB;
constexpr size_t W_END = 448 * MiB;
constexpr size_t T_LAM = 0, T_A = 4096, T_A64 = 20480, T_SMETA = 36864, T_BCT = 65536, T_CCT = 196608, T_S = 1 * MiB;
constexpr int CW_TMO = 0, CW_CODE = 1, CW_BAR = 4096, CW_QCTR = 8192, CW_ECNT = 12288;

__device__ __forceinline__ unsigned cvtpk(float lo, float hi) { unsigned r; asm volatile("v_cvt_pk_bf16_f32 %0, %1, %2" : "=v"(r) : "v"(lo), "v"(hi)); return r; }
typedef short s16x4 __attribute__((ext_vector_type(4)));
typedef float f32x16 __attribute__((ext_vector_type(16)));
typedef unsigned u32x4 __attribute__((ext_vector_type(4)));
typedef unsigned u32x2 __attribute__((ext_vector_type(2)));
#define SBAR() __builtin_amdgcn_sched_barrier(0)

__device__ __forceinline__ void tr_item(const float* __restrict__ W, int ldw, int K, bf16_t* WT, int k0, int n0, int drow0, float sc, LAS float* scr, int lane) {
#pragma unroll 8
    for (int i = 0; i < 32; ++i) { const int kk = 2 * i + (lane >> 5); scr[kk * 33 + (lane & 31)] = W[(size_t)(k0 + kk) * ldw + n0 + (lane & 31)]; }
    LDS_WAIT(); asm volatile("" ::: "memory");
    const int c = lane & 7;
#pragma unroll
    for (int j = 0; j < 4; ++j) { const int n = (lane >> 3) + 8 * j; const LAS float* s = scr + (8 * c) * 33 + n;
        v4u o; o.x = cvtpk(s[0 * 33] * sc, s[1 * 33] * sc); o.y = cvtpk(s[2 * 33] * sc, s[3 * 33] * sc); o.z = cvtpk(s[4 * 33] * sc, s[5 * 33] * sc); o.w = cvtpk(s[6 * 33] * sc, s[7 * 33] * sc);
        *(GAS v4u*)(WT + (size_t)(drow0 + n) * K + k0 + 8 * c) = o; }
    LDS_WAIT(); asm volatile("" ::: "memory");
}
struct MkArgs { const void* p[31]; int ph_lo, ph_hi, flags, pad; };
__device__ __forceinline__ const float* argf(const MkArgs& a, int k) { asm volatile("" : "+s"(k)); return (const float*)a.p[k]; }
__device__ __forceinline__ unsigned char* argws(const MkArgs& a) { int k = 30; asm volatile("" : "+s"(k)); return (unsigned char*)a.p[k]; }
__device__ __forceinline__ int argi(const MkArgs& a, int k) { asm volatile("" : "+s"(k)); return (&a.ph_lo)[k]; }
__device__ __forceinline__ float* argout(const MkArgs& a) { int k = 29; asm volatile("" : "+s"(k)); return (float*)a.p[k]; }

__device__ __forceinline__ void p0_prologue(const MkArgs& a, LAS unsigned char* lds, int gw, int NGW, int wave, int lane) {
    LAS float* scr = (LAS float*)(lds + wave * 16384);
    unsigned char* ws = argws(a);
    constexpr int I_IN = 2 * 16 * 80, I_OUT = 2 * 16 * 32, I_GLU = 2 * 4 * 16, I_W1 = 16 * 88, I_W3 = 16 * 88, I_W2 = 44 * 32;
    constexpr int I_E1 = 8 * 16 * 112, I_E3 = I_E1, I_E2 = 8 * 56 * 32;
    constexpr int NITEMS = I_IN + I_OUT + I_GLU + I_W1 + I_W3 + I_W2 + I_E1 + I_E3 + I_E2;
    for (int it = gw; it < NITEMS; it += NGW) {
        int r = it;
        if (r < I_IN) { const int l = r / (16 * 80), q = r % (16 * 80), kb = q / 80, nb = q % 80, n0 = 32 * nb;
            const float sc = ((n0 >= C_DQ && n0 < C_DK) || (n0 >= C_FQ && n0 < C_FK)) ? QSCALE : 1.0f;
            tr_item(argf(a, 3) + (size_t)l * D * INW, INW, D, (bf16_t*)(ws + W_WIN) + (size_t)l * ZW * D, 64 * kb, n0, n0, sc, scr, lane); continue; } r -= I_IN;
        if (r < I_OUT) { const int l = r / (16 * 32), q = r % (16 * 32), kb = q / 32, nb = q % 32;
            tr_item(argf(a, 4) + (size_t)l * D * D, D, D, (bf16_t*)(ws + W_WOUT) + (size_t)l * D * D, 64 * kb, 32 * nb, 32 * nb, 1.0f, scr, lane); continue; } r -= I_OUT;
        if (r < I_GLU) { const int l = r / 64, q = r % 64, kb = q / 16, nb = q % 16;
            tr_item(argf(a, 13) + (size_t)l * 256 * 512, 512, 256, (bf16_t*)(ws + W_WGLU) + (size_t)l * 512 * 256, 64 * kb, 32 * nb, 32 * nb, 1.0f, scr, lane); continue; } r -= I_GLU;
        if (r < I_W1 + I_W3) { const int which = r >= I_W1; if (which) r -= I_W1; const int kb = r / 88, nb = r % 88, n0 = 32 * nb;
            const int drow = 256 * (n0 / 128) + 128 * which + (n0 % 128);
            tr_item(argf(a, which ? 22 : 21), FFD, D, (bf16_t*)(ws + W_W13), 64 * kb, n0, drow, 1.0f, scr, lane); continue; } r -= I_W1 + I_W3;
        if (r < I_W2) { const int kb = r / 32, nb = r % 32;
            tr_item(argf(a, 23), D, FFD, (bf16_t*)(ws + W_W2), 64 * kb, 32 * nb, 32 * nb, 1.0f, scr, lane); continue; } r -= I_W2;
        if (r < I_E1 + I_E3) { const int which = r >= I_E1; if (which) r -= I_E1; const int e = r / (16 * 112), q = r % (16 * 112), kb = q / 112, nb = q % 112, n0 = 32 * nb;
            const int drow = 256 * (n0 / 128) + 128 * which + (n0 % 128);
            tr_item(argf(a, which ? 26 : 25) + (size_t)e * D * FFE, FFE, D, (bf16_t*)(ws + W_WE13) + (size_t)e * 2 * FFE * D, 64 * kb, n0, drow, 1.0f, scr, lane); continue; } r -= I_E1 + I_E3;
        { const int e = r / (56 * 32), q = r % (56 * 32), kb = q / 32, nb = q % 32;
            tr_item(argf(a, 27) + (size_t)e * FFE * D, D, FFE, (bf16_t*)(ws + W_WE2) + (size_t)e * D * FFE, 64 * kb, 32 * nb, 32 * nb, 1.0f, scr, lane); }
    }
    const int gt = gw * 64 + lane;
    if (gt < 2048) {
        const int l = gt >> 10, g = (gt >> 6) & 15, n = gt & 63;
        const float* lam_re = argf(a, 5) + l * 1024; const float* lam_im = argf(a, 6) + l * 1024; const float* log_dt = argf(a, 7) + l * 16;
        const double dt = exp_small((double)log_dt[g]);
        const double lr = (double)lam_re[g * 64 + n], li = (double)lam_im[g * 64 + n];
        const double mag = exp_small(lr * dt); double sn, cs; sincos_d(li * dt, sn, cs);
        const double ar = mag * cs, ai = mag * sn, den = lr * lr + li * li, nr = ar - 1.0, ni = ai;
        const float cre = (float)((nr * lr + ni * li) / den), cim = (float)((ni * lr - nr * li) / den);
        double pr = ar, pi = ai;
#pragma unroll
        for (int i = 0; i < 6; ++i) { const double t = pr * pr - pi * pi; pi = 2.0 * pr * pi; pr = t; }
        ((float2*)(ws + W_TAB + T_A))[gt] = make_float2((float)ar, (float)ai);
        ((float2*)(ws + W_TAB + T_A64))[gt] = make_float2((float)pr, (float)pi);
        const float* b_re = argf(a, 8) + (size_t)l * 16384 + (g * 64 + n) * 16; const float* b_im = argf(a, 9) + (size_t)l * 16384 + (g * 64 + n) * 16;
        bf16_t* bct = (bf16_t*)(ws + W_TAB + T_BCT) + (size_t)(l * 16 + g) * 128 * 16;
#pragma unroll
        for (int c = 0; c < 16; ++c) { const float r = b_re[c], i = b_im[c]; bct[n * 16 + c] = f2bf(cre * r - cim * i); bct[(64 + n) * 16 + c] = f2bf(cre * i + cim * r); }
        const float* c_re = argf(a, 10) + (size_t)l * 16384 + g * 1024; const float* c_im = argf(a, 11) + (size_t)l * 16384 + g * 1024;
        bf16_t* cct = (bf16_t*)(ws + W_TAB + T_CCT) + (size_t)(l * 16 + g) * 16 * 128;
#pragma unroll
        for (int c = 0; c < 16; ++c) { cct[c * 128 + n] = f2bf(c_re[c * 64 + n]); cct[c * 128 + 64 + n] = f2bf(-c_im[c * 64 + n]); }
    }
    if (gt < 2) {
        const int l = gt; float s1 = 0.f, s2 = 0.f;
        for (int i = 0; i < 64; ++i) { s1 += argf(a, 14)[l * 64 + i] * argf(a, 15)[l * 64 + i]; s2 += argf(a, 16)[l * 64 + i] * argf(a, 17)[l * 64 + i]; }
        const float lam_init = 0.8f - 0.6f * expf(-0.3f * (float)l);
        float* lamp = (float*)(ws + W_TAB + T_LAM); lamp[2 * l] = expf(s1) - expf(s2) + lam_init; lamp[2 * l + 1] = 1.0f - lam_init;
    }
}

__device__ __forceinline__ void norm_rows(const RowSrc& s, const float* g, const float* wfg, bf16_t* hbuf, float* fgbuf, int gw, int NGW, int lane, int nrows) {
    for (int r = gw; r < nrows; r += NGW) {
        unsigned long long* o8 = (unsigned long long*)(hbuf + (size_t)r * D) + lane;
        if (r >= MVALID) {
#pragma unroll
            for (int j = 0; j < 4; ++j) o8[64 * j] = 0ull;
            continue;
        }
        const float4* p = (const float4*)res_row(s, r) + lane;
        float4 v[4]; float ss = 0.f;
#pragma unroll
        for (int j = 0; j < 4; ++j) { v[j] = p[64 * j]; ss += v[j].x * v[j].x + v[j].y * v[j].y + v[j].z * v[j].z + v[j].w * v[j].w; }
        ss = wave_sum(ss);
        const float rstd = 1.0f / sqrtf(ss * (1.0f / D) + EPS);
#pragma unroll
        for (int j = 0; j < 4; ++j) {
            const float4 gj = ((const float4*)g)[lane + 64 * j];
            v[j].x = v[j].x * rstd * gj.x; v[j].y = v[j].y * rstd * gj.y; v[j].z = v[j].z * rstd * gj.z; v[j].w = v[j].w * rstd * gj.w;
            o8[64 * j] = (unsigned long long)cvtpk(v[j].x, v[j].y) | ((unsigned long long)cvtpk(v[j].z, v[j].w) << 32);
        }
        if (wfg) {
            float a[4] = {0.f, 0.f, 0.f, 0.f};
#pragma unroll
            for (int j = 0; j < 4; ++j) {
                const int k = 256 * j + 4 * lane;
                const float hv[4] = {v[j].x, v[j].y, v[j].z, v[j].w};
#pragma unroll
                for (int i = 0; i < 4; ++i) {
                    const float4 w = *(const float4*)(wfg + (size_t)(k + i) * INW);
                    a[0] += hv[i] * w.x; a[1] += hv[i] * w.y; a[2] += hv[i] * w.z; a[3] += hv[i] * w.w;
                }
            }
#pragma unroll
            for (int c = 0; c < 4; ++c) a[c] = wave_sum(a[c]);
            if (lane == 0) *(float4*)(fgbuf + (size_t)r * 4) = make_float4(a[0], a[1], a[2], a[3]);
        }
    }
}

namespace pg8 {
struct EpiSwiglu {
    static constexpr bool PERM = true, AFTER_DRAIN = false;
    bf16_t* H; int ldh; int pad;
    __device__ __forceinline__ void operator()(const f32x4 (&acc)[2][2][4][2], const Unit& u, int wr, int wc, int fr, int fq) const {
        const int row0 = u.pm * BM + wr * 64 + fr, col0 = u.pn * HALF + wc * 32 + 8 * fq;
#pragma unroll
        for (int ai = 0; ai < 2; ++ai)
#pragma unroll
            for (int m = 0; m < 4; ++m) {
                bf16_t* rowp = H + (size_t)(row0 + ai * HALF + m * 16) * ldh + col0;
                float h[8];
#pragma unroll
                for (int n = 0; n < 2; ++n)
#pragma unroll
                    for (int e = 0; e < 4; ++e) { const float x = acc[ai][0][m][n][e], y = acc[ai][1][m][n][e];
                        h[4 * n + e] = x * __builtin_amdgcn_rcpf(1.0f + __builtin_amdgcn_exp2f(-x * LOG2E)) * y; }
                u32x4 w; w.x = cvt_pk_bf16(h[0], h[1]); w.y = cvt_pk_bf16(h[2], h[3]); w.z = cvt_pk_bf16(h[4], h[5]); w.w = cvt_pk_bf16(h[6], h[7]);
                *(u32x4*)rowp = w;
            }
    }
};
struct EpiResF32 {
    static constexpr bool PERM = false, AFTER_DRAIN = false;
    RowSrc src; float* dout; float* resm;
    __device__ __forceinline__ void operator()(const f32x4 (&acc)[2][2][4][2], const Unit& u, int wr, int wc, int fr, int fq) const {
#pragma unroll
        for (int ai = 0; ai < 2; ++ai)
#pragma unroll
            for (int m = 0; m < 4; ++m) {
                const int r = u.pm * BM + ai * HALF + wr * 64 + m * 16 + fr;
                const float* bp = res_row(src, r); float* op = r < MAIN ? dout + (size_t)r * D : resm + (size_t)(r - MAIN) * D;
#pragma unroll
                for (int bj = 0; bj < 2; ++bj)
#pragma unroll
                    for (int n = 0; n < 2; ++n) { const int c = u.pn * BM + bj * HALF + wc * 32 + n * 16 + 4 * fq;
                        const f32x4 b = *(const f32x4*)(bp + c); *(f32x4*)(op + c) = b + acc[ai][bj][m][n]; }
            }
    }
};
template <bool GATH> struct MoeOrder : StaticOrder {
    static constexpr bool GATHER = GATH;
    int pb1, pb2, pb3, pb4, pb5, pb6, pb7;
    int c0, c1, c2, c3, c4, c5, c6, c7;
    size_t estride;
    const int* list;
    __device__ __forceinline__ int setup(const gu32* ecnt) {
        c0 = (int)__hip_atomic_load(ecnt + 0, RLX_AGENT); c1 = (int)__hip_atomic_load(ecnt + 64, RLX_AGENT); c2 = (int)__hip_atomic_load(ecnt + 128, RLX_AGENT); c3 = (int)__hip_atomic_load(ecnt + 192, RLX_AGENT);
        c4 = (int)__hip_atomic_load(ecnt + 256, RLX_AGENT); c5 = (int)__hip_atomic_load(ecnt + 320, RLX_AGENT); c6 = (int)__hip_atomic_load(ecnt + 384, RLX_AGENT); c7 = (int)__hip_atomic_load(ecnt + 448, RLX_AGENT);
        pb1 = (c0 + 255) >> 8; pb2 = pb1 + ((c1 + 255) >> 8); pb3 = pb2 + ((c2 + 255) >> 8); pb4 = pb3 + ((c3 + 255) >> 8);
        pb5 = pb4 + ((c4 + 255) >> 8); pb6 = pb5 + ((c5 + 255) >> 8); pb7 = pb6 + ((c6 + 255) >> 8);
        return pb7 + ((c7 + 255) >> 8);
    }
    __device__ __forceinline__ int pbase_of(int e) const { int r = 0; if (e == 1) r = pb1; if (e == 2) r = pb2; if (e == 3) r = pb3; if (e == 4) r = pb4; if (e == 5) r = pb5; if (e == 6) r = pb6; if (e == 7) r = pb7; return r; }
    __device__ __forceinline__ void locate(int pm, int& e, int& base, int& cnt) const {
        e = 0; base = 0; cnt = c0;
        if (pm >= pb1) { e = 1; base = pb1; cnt = c1; } if (pm >= pb2) { e = 2; base = pb2; cnt = c2; } if (pm >= pb3) { e = 3; base = pb3; cnt = c3; }
        if (pm >= pb4) { e = 4; base = pb4; cnt = c4; } if (pm >= pb5) { e = 5; base = pb5; cnt = c5; } if (pm >= pb6) { e = 6; base = pb6; cnt = c6; }
        if (pm >= pb7) { e = 7; base = pb7; cnt = c7; }
    }
    __device__ __forceinline__ const char* a_ptr(const Gemm& g, const Unit& u) const { return GATH ? (const char*)g.A : (const char*)g.A + (size_t)u.pm * ((size_t)BM * g.K * 2); }
    __device__ __forceinline__ const char* b_ptr(const Gemm& g, const Unit& u) const { int e, base, cnt; locate(u.pm, e, base, cnt); return (const char*)g.Bt + (size_t)e * estride + (size_t)u.pn * ((size_t)BM * g.K * 2); }
    __device__ __forceinline__ void gather_offs(const Gemm& g, const Unit& u, const int (&R)[2], const int (&C)[2], unsigned (&vo)[2][2]) const {
        int e, base, cnt; locate(u.pm, e, base, cnt);
        const int p0 = (u.pm - base) * BM;
#pragma unroll
        for (int h = 0; h < 2; ++h)
#pragma unroll
            for (int i = 0; i < 2; ++i) { const int p = p0 + h * HALF + R[i]; int tok = 0; if (p < cnt) tok = list[e * 16384 + p];
                vo[h][i] = (unsigned)(tok * g.K + C[i]) * 2u; }
    }
};
}

namespace att {
#define KSWZ(row, colB) ((row) * 256 + ((colB) ^ (((row) & 7) << 4)))
constexpr int SHM_V = 16384, SHM_K = 16384;
constexpr int L_V = 0, L_K = 2 * SHM_V, L_CK = 65536, L_WS = 65536 + 1024;
__device__ __forceinline__ int crow(int r, int hi) { return (r & 3) + 8 * (r >> 2) + 4 * hi; }
__device__ __forceinline__ int v_st(int k, int c) { const int kk = (k & ~0xC) | ((k & 4) << 1) | ((k & 8) >> 1); return ((kk >> 3) * 4 + (c >> 5)) * 512 + ((kk & 7) * 32 + (c & 31)) * 2; }
__device__ __forceinline__ int v_rd_base(int lane) { return ((lane & 3) << 3) | (((lane >> 2) & 3) << 6) | (((lane >> 4) & 1) << 5) | (((lane >> 5) & 1) << 8); }
constexpr int v_rd_off(int d0, int ks, int half) { return d0 * 512 + ks * 4096 + half * 2048; }
template <int OFF> __device__ __forceinline__ s16x4 tr_read(int vb) {
    s16x4 r; asm volatile("ds_read_b64_tr_b16 %0, %1 offset:%2" : "=&v"(r) : "v"(vb), "i"(OFF) : "memory"); return r;
}
template <int D0> __device__ __forceinline__ void pv_one(f32x16& od, int vb, bf16x8 pa0, bf16x8 pa1, bf16x8 pa2, bf16x8 pa3) {
    const s16x4 l0 = tr_read<v_rd_off(D0, 0, 0)>(vb), h0 = tr_read<v_rd_off(D0, 0, 1)>(vb), l1 = tr_read<v_rd_off(D0, 1, 0)>(vb), h1 = tr_read<v_rd_off(D0, 1, 1)>(vb);
    const s16x4 l2 = tr_read<v_rd_off(D0, 2, 0)>(vb), h2 = tr_read<v_rd_off(D0, 2, 1)>(vb), l3 = tr_read<v_rd_off(D0, 3, 0)>(vb), h3 = tr_read<v_rd_off(D0, 3, 1)>(vb);
    asm volatile("s_waitcnt lgkmcnt(0)" ::: "memory"); SBAR();
#define PK(L, H) (bf16x8){L[0], L[1], L[2], L[3], H[0], H[1], H[2], H[3]}
    od = __builtin_amdgcn_mfma_f32_32x32x16_bf16(pa0, PK(l0, h0), od, 0, 0, 0);
    od = __builtin_amdgcn_mfma_f32_32x32x16_bf16(pa1, PK(l1, h1), od, 0, 0, 0);
    od = __builtin_amdgcn_mfma_f32_32x32x16_bf16(pa2, PK(l2, h2), od, 0, 0, 0);
    od = __builtin_amdgcn_mfma_f32_32x32x16_bf16(pa3, PK(l3, h3), od, 0, 0, 0);
#undef PK
}

template <bool FOX>
__device__ __forceinline__ void attn_unit(int hsel, int b, int i, const bf16_t* z, const float* cum, float lam, float oml, const float* subg, bf16_t* mix, char* lds) {
    int tid_ = threadIdx.x; asm volatile("" : "+v"(tid_));
    const int tid = tid_, lane = tid & 63, r32 = lane & 31, hi = lane >> 5;
    const int wid = __builtin_amdgcn_readfirstlane(tid >> 6), half = wid >> 2, wq = wid & 3;
    const bool meta = (b == NB);
    const int qrow0 = meta ? MAIN : b * SEQ + 128 * i;
    const int kvmain0 = meta ? 0 : b * SEQ;
    const int nmain = meta ? 0 : 2 * i + 2, NT = nmain + 1;
    const int qcol = (FOX ? C_FQ : C_DQ) + 128 * hsel + 64 * half;
    const int kcol = (FOX ? C_FK : C_DK) + 128 * hsel, vcol = (FOX ? C_FV : C_DV) + 128 * hsel;
    const int qrel = 32 * wq + r32;
    const int qpos = meta ? qrel - 16 : 128 * i + qrel;
    float* wsf = (float*)(lds + L_WS) + wid * 64;
    float* ckb = (float*)(lds + L_CK);
    bf16x8 qr[4];
    {
        const bf16_t* Qw = z + (size_t)(qrow0 + qrel) * ZW + qcol + hi * 8;
#pragma unroll
        for (int d0 = 0; d0 < 4; ++d0) qr[d0] = *(const bf16x8*)(Qw + d0 * 16);
    }
    float cq = 0.f;
    if (FOX) cq = cum[(size_t)(qrow0 + qrel) * 4 + 2 * hsel + half];
    const int sr = tid >> 4, sc = (tid & 15) * 8, vst0 = v_st(sr, sc), vst1 = v_st(32 + sr, sc);
    const int vb0 = (int)(uintptr_t)(lds + L_V) + v_rd_base(lane);
    bf16x8 sk0, sk1, sv0, sv1; float sck = 0.f;
#define TROW(t) ((t) == 0 ? MAIN : kvmain0 + 64 * ((t) - 1))
#define SLOAD(t) do { const bf16_t* base_ = z + (size_t)(TROW(t) + sr) * ZW; \
        sk0 = *(const bf16x8*)(base_ + kcol + sc); sk1 = *(const bf16x8*)(base_ + (size_t)32 * ZW + kcol + sc); \
        sv0 = *(const bf16x8*)(base_ + vcol + sc); sv1 = *(const bf16x8*)(base_ + (size_t)32 * ZW + vcol + sc); \
        if (FOX && tid < 128) sck = cum[(size_t)(TROW(t) + (tid & 63)) * 4 + 2 * hsel + (tid >> 6)]; } while (0)
#define SWRITE(bf) do { *(bf16x8*)(lds + L_V + (bf) * SHM_V + vst0) = sv0; *(bf16x8*)(lds + L_V + (bf) * SHM_V + vst1) = sv1; \
        *(bf16x8*)(lds + L_K + (bf) * SHM_K + KSWZ(sr, sc * 2)) = sk0; *(bf16x8*)(lds + L_K + (bf) * SHM_K + KSWZ(32 + sr, sc * 2)) = sk1; \
        if (FOX && tid < 128) ckb[(bf) * 128 + tid] = sck; } while (0)
    float m_reg = -1e30f, l_reg = 0.f; f32x16 o[4];
#pragma unroll
    for (int d = 0; d < 4; ++d) o[d] = f32x16{};
    SLOAD(0); SWRITE(0); __syncthreads();
    for (int t = 0; t < NT; ++t) {
        const int bf = t & 1;
        if (t + 1 < NT) SLOAD(t + 1);
        f32x16 p0 = f32x16{}, p1 = f32x16{};
        {
            const char* Ks = lds + L_K + bf * SHM_K;
#pragma unroll
            for (int d0 = 0; d0 < 4; ++d0) { const int cb = ((4 * half + d0) * 16 + hi * 8) * 2;
                const bf16x8 b0 = *(const bf16x8*)(Ks + KSWZ(r32, cb)), b1 = *(const bf16x8*)(Ks + KSWZ(32 + r32, cb));
                p0 = __builtin_amdgcn_mfma_f32_32x32x16_bf16(b0, qr[d0], p0, 0, 0, 0);
                p1 = __builtin_amdgcn_mfma_f32_32x32x16_bf16(b1, qr[d0], p1, 0, 0, 0); }
        }
        if (FOX) {
            const float* ck = ckb + bf * 128 + half * 64;
#pragma unroll
            for (int g = 0; g < 4; ++g) { const float4 c0 = *(const float4*)(ck + 8 * g + 4 * hi), c1 = *(const float4*)(ck + 32 + 8 * g + 4 * hi);
                p0[4 * g + 0] += cq - c0.x; p0[4 * g + 1] += cq - c0.y; p0[4 * g + 2] += cq - c0.z; p0[4 * g + 3] += cq - c0.w;
                p1[4 * g + 0] += cq - c1.x; p1[4 * g + 1] += cq - c1.y; p1[4 * g + 2] += cq - c1.z; p1[4 * g + 3] += cq - c1.w; }
        }
        if (t == 0 || t - 1 >= 2 * i) {
            int lim; if (t == 0) { lim = qpos + 16; if (lim > 15) lim = 15; } else lim = qpos - 64 * (t - 1);
#pragma unroll
            for (int r = 0; r < 16; ++r) { const int kk = crow(r, hi); if (kk > lim) p0[r] = -INFINITY; if (kk + 32 > lim) p1[r] = -INFINITY; }
        }
        float pmax = p0[0];
#pragma unroll
        for (int r = 1; r < 16; ++r) pmax = fmaxf(pmax, p0[r]);
#pragma unroll
        for (int r = 0; r < 16; ++r) pmax = fmaxf(pmax, p1[r]);
        { auto rr = __builtin_amdgcn_permlane32_swap(__float_as_uint(pmax), __float_as_uint(pmax), false, false);
          pmax = fmaxf(__uint_as_float(rr[0]), __uint_as_float(rr[1])); }
        const float mn = fmaxf(m_reg, pmax);
        const float alpha = __builtin_amdgcn_exp2f(m_reg - mn); m_reg = mn;
        float ps = 0.f;
#pragma unroll
        for (int r = 0; r < 16; ++r) { p0[r] = __builtin_amdgcn_exp2f(p0[r] - mn); ps += p0[r]; }
#pragma unroll
        for (int r = 0; r < 16; ++r) { p1[r] = __builtin_amdgcn_exp2f(p1[r] - mn); ps += p1[r]; }
        { auto rr = __builtin_amdgcn_permlane32_swap(__float_as_uint(ps), __float_as_uint(ps), false, false);
          ps = __uint_as_float(rr[0]) + __uint_as_float(rr[1]); }
        l_reg = l_reg * alpha + ps;
        if (__any(alpha < 1.f)) {
            if (hi == 0) wsf[r32] = alpha;
            asm volatile("s_waitcnt lgkmcnt(0)" ::: "memory");
#pragma unroll
            for (int d = 0; d < 4; ++d)
#pragma unroll
                for (int r = 0; r < 16; ++r) o[d][r] *= wsf[crow(r, hi)];
            asm volatile("s_waitcnt lgkmcnt(0)" ::: "memory");
        }
        bf16x8 pa0, pa1, pa2, pa3;
#define PK4(P, BASE, OUT) do { unsigned a0 = cvtpk(P[BASE + 0], P[BASE + 1]), a1 = cvtpk(P[BASE + 2], P[BASE + 3]);   \
        unsigned b0 = cvtpk(P[BASE + 4], P[BASE + 5]), b1 = cvtpk(P[BASE + 6], P[BASE + 7]);                              \
        auto r0 = __builtin_amdgcn_permlane32_swap(a0, b0, false, false); auto r1 = __builtin_amdgcn_permlane32_swap(a1, b1, false, false); \
        u32x4 w = {r0[0], r1[0], r0[1], r1[1]}; OUT = *reinterpret_cast<bf16x8*>(&w); } while (0)
        PK4(p0, 0, pa0); PK4(p0, 8, pa1); PK4(p1, 0, pa2); PK4(p1, 8, pa3);
#undef PK4
        SBAR();
        const int vb = vb0 + bf * SHM_V;
        if (!FOX) { pv_one<0>(o[0], vb, pa0, pa1, pa2, pa3); pv_one<1>(o[1], vb, pa0, pa1, pa2, pa3); pv_one<2>(o[2], vb, pa0, pa1, pa2, pa3); pv_one<3>(o[3], vb, pa0, pa1, pa2, pa3); }
        else if (half == 0) { pv_one<0>(o[0], vb, pa0, pa1, pa2, pa3); pv_one<1>(o[1], vb, pa0, pa1, pa2, pa3); }
        else { pv_one<2>(o[0], vb, pa0, pa1, pa2, pa3); pv_one<3>(o[1], vb, pa0, pa1, pa2, pa3); }
        if (t + 1 < NT) SWRITE(bf ^ 1);
        __syncthreads();
    }
    if (hi == 0) wsf[32 + r32] = l_reg;
    asm volatile("s_waitcnt lgkmcnt(0)" ::: "memory");
    float rli[16];
#pragma unroll
    for (int r = 0; r < 16; ++r) rli[r] = 1.0f / wsf[32 + crow(r, hi)];
    const int nvalid = meta ? NMETA : 128;
    if (FOX) {
#pragma unroll
        for (int r = 0; r < 16; ++r) { const int rr = 32 * wq + crow(r, hi);
            if (rr < nvalid) {
                bf16_t* op = mix + (size_t)(qrow0 + rr) * D + 768 + 128 * hsel + 64 * half + r32;
                op[0] = f2bf(o[0][r] * rli[r]); op[32] = f2bf(o[1][r] * rli[r]); } }
    } else {
        float* xb = (float*)lds;
        if (half == 1) {
#pragma unroll
            for (int r = 0; r < 16; ++r) { const float f = rli[r] * lam; const int rr = 32 * wq + crow(r, hi);
#pragma unroll
                for (int d = 0; d < 4; ++d) xb[rr * 128 + 32 * d + r32] = o[d][r] * f; }
        }
        __syncthreads();
        if (half == 0) {
            float ssq[16];
#pragma unroll
            for (int r = 0; r < 16; ++r) { const int rr = 32 * wq + crow(r, hi); float s = 0.f;
#pragma unroll
                for (int d = 0; d < 4; ++d) { const float v = o[d][r] * rli[r] - xb[rr * 128 + 32 * d + r32]; o[d][r] = v; s += v * v; }
                ssq[r] = s; }
#pragma unroll
            for (int r = 0; r < 16; ++r) {
                float s = ssq[r];
                s += __shfl_xor(s, 1); s += __shfl_xor(s, 2); s += __shfl_xor(s, 4); s += __shfl_xor(s, 8); s += __shfl_xor(s, 16);
                ssq[r] = oml / sqrtf(s * (1.0f / 128.0f) + EPS);
            }
            float gsub[4];
#pragma unroll
            for (int d = 0; d < 4; ++d) gsub[d] = subg[32 * d + r32];
#pragma unroll
            for (int r = 0; r < 16; ++r) { const int rr = 32 * wq + crow(r, hi);
                if (rr < nvalid) {
                    bf16_t* op = mix + (size_t)(qrow0 + rr) * D + 256 + 128 * hsel + r32;
#pragma unroll
                    for (int d = 0; d < 4; ++d) op[32 * d] = f2bf(o[d][r] * ssq[r] * gsub[d]); } }
        }
        __syncthreads();
    }
#undef TROW
#undef SLOAD
#undef SWRITE
}
#undef KSWZ
}

namespace ssm {
constexpr int UST = 528;
constexpr int L_U = 0, L_W = 33792, WREG = 12800, L_BW = 0, BWST = 132  , L_X = 8448, XST = 272;
template <bool PASS_C>
__device__ __forceinline__ void ssm_unit(int l, int b, int c, const bf16_t* z, const unsigned char* tab, float2* Sbuf, float2* Smeta, const float* dskip, const bf16_t* wglu_t, bf16_t* mix, char* lds) {
    int tid_ = threadIdx.x; asm volatile("" : "+v"(tid_));
    const int tid = tid_, lane = tid & 63, fr = lane & 15, fq = lane >> 4;
    const int wid = __builtin_amdgcn_readfirstlane(tid >> 6);
    const bool meta = (b == NB);
    const int row0 = meta ? MAIN : b * SEQ + 64 * c;
    const int nsb = meta ? 1 : 4;
    {
        const int row = tid >> 3;
#pragma unroll
        for (int q = 0; q < 4; ++q) { const int c16 = (tid & 7) + 8 * q;
            const bf16x8 v = *(const bf16x8*)(z + (size_t)(row0 + row) * ZW + c16 * 8);
            *(bf16x8*)(lds + L_U + row * UST + c16 * 16) = v; }
    }
    __syncthreads();
    char* wreg = lds + L_W + wid * WREG;
    float* bw = (float*)(wreg + L_BW);
    char* xw = wreg + L_X;
    const float2* Atab = (const float2*)(tab + T_A) + l * 1024;
    const float2* A64tab = (const float2*)(tab + T_A64) + l * 1024;
    const bf16_t* Bct = (const bf16_t*)(tab + T_BCT) + (size_t)l * 16 * 128 * 16;
    const bf16_t* Cct = (const bf16_t*)(tab + T_CCT) + (size_t)l * 16 * 16 * 128;
    for (int gi = 0; gi < 2; ++gi) {
        const int g = wid * 2 + gi;
        const float2 A = Atab[g * 64 + lane];
        bf16x8 Bf[8];
#pragma unroll
        for (int tl = 0; tl < 8; ++tl) { Bf[tl] = bf16x8{}; if (fq < 2) Bf[tl] = *(const bf16x8*)(Bct + (size_t)(g * 128 + 16 * tl + fr) * 16 + 8 * fq); }
        bf16x8 Cf[4]; float dsk[4];
        if (PASS_C) {
#pragma unroll
            for (int ks = 0; ks < 4; ++ks) Cf[ks] = *(const bf16x8*)(Cct + (size_t)(g * 16 + fr) * 128 + 32 * ks + 8 * fq);
#pragma unroll
            for (int e = 0; e < 4; ++e) dsk[e] = dskip[g * 16 + 4 * fq + e];
        }
        float xr = 0.f, xi = 0.f;
        if (PASS_C && !meta) {
            const float2 A64 = A64tab[g * 64 + lane];
            const float2 sm = Smeta[g * 64 + lane]; xr = sm.x; xi = sm.y;
            for (int j = 0; j < c; ++j) { const float2 s = Sbuf[((size_t)(b * 32 + j) * 16 + g) * 64 + lane];
                const float nr = A64.x * xr - A64.y * xi + s.x, ni = A64.x * xi + A64.y * xr + s.y; xr = nr; xi = ni; }
        }
        for (int sb = 0; sb < nsb; ++sb) {
            bf16x8 ua = bf16x8{};
            if (fq < 2) ua = *(const bf16x8*)(lds + L_U + (16 * sb + fr) * UST + (16 * g + 8 * fq) * 2);
#pragma unroll
            for (int tl = 0; tl < 8; ++tl) {
                f32x4 acc = {0.f, 0.f, 0.f, 0.f};
                acc = __builtin_amdgcn_mfma_f32_16x16x32_bf16(ua, Bf[tl], acc, 0, 0, 0);
#pragma unroll
                for (int e = 0; e < 4; ++e) bw[(4 * fq + e) * BWST + 16 * tl + fr] = acc[e];
            }
            asm volatile("s_waitcnt lgkmcnt(0)" ::: "memory");
#pragma unroll
            for (int t = 0; t < 16; ++t) {
                const float re = bw[t * BWST + lane], im = bw[t * BWST + 64 + lane];
                const float nr = A.x * xr - A.y * xi + re, ni = A.x * xi + A.y * xr + im; xr = nr; xi = ni;
                if (PASS_C) { ((bf16_t*)(xw + t * XST))[lane] = f2bf(xr); ((bf16_t*)(xw + t * XST))[64 + lane] = f2bf(xi); }
            }
            asm volatile("s_waitcnt lgkmcnt(0)" ::: "memory");
            if (PASS_C) {
                f32x4 acc = {0.f, 0.f, 0.f, 0.f};
#pragma unroll
                for (int ks = 0; ks < 4; ++ks) { const bf16x8 xb = *(const bf16x8*)(xw + fr * XST + (32 * ks + 8 * fq) * 2);
                    acc = __builtin_amdgcn_mfma_f32_16x16x32_bf16(Cf[ks], xb, acc, 0, 0, 0); }
                u32x2* up = (u32x2*)(lds + L_U + (16 * sb + fr) * UST + (16 * g + 4 * fq) * 2);
                const u32x2 uu = *up;
                const float u0 = __uint_as_float(uu.x << 16), u1 = __uint_as_float(uu.x & 0xffff0000u), u2 = __uint_as_float(uu.y << 16), u3 = __uint_as_float(uu.y & 0xffff0000u);
                const float y0 = gelu_tanh(acc[0] + dsk[0] * u0), y1 = gelu_tanh(acc[1] + dsk[1] * u1), y2 = gelu_tanh(acc[2] + dsk[2] * u2), y3 = gelu_tanh(acc[3] + dsk[3] * u3);
                u32x2 w; w.x = cvtpk(y0, y1); w.y = cvtpk(y2, y3); *up = w;
                asm volatile("s_waitcnt lgkmcnt(0)" ::: "memory");
            }
        }
        if (!PASS_C) {
            if (meta) Smeta[g * 64 + lane] = make_float2(xr, xi);
            else Sbuf[((size_t)(b * 32 + c) * 16 + g) * 64 + lane] = make_float2(xr, xi);
        }
    }
    __syncthreads();
    if (PASS_C) {
        const int r32 = lane & 31, hi = lane >> 5;
        f32x16 a00 = f32x16{}, a01 = f32x16{}, a10 = f32x16{}, a11 = f32x16{};
        const bf16_t* w1p = wglu_t + (size_t)(32 * wid + r32) * 256 + 8 * hi;
        const bf16_t* w2p = wglu_t + (size_t)(256 + 32 * wid + r32) * 256 + 8 * hi;
#pragma unroll 4
        for (int ks = 0; ks < 16; ++ks) {
            const bf16x8 wa = *(const bf16x8*)(w1p + 16 * ks), wb = *(const bf16x8*)(w2p + 16 * ks);
            const bf16x8 y0 = *(const bf16x8*)(lds + L_U + r32 * UST + (16 * ks + 8 * hi) * 2), y1 = *(const bf16x8*)(lds + L_U + (32 + r32) * UST + (16 * ks + 8 * hi) * 2);
            a00 = __builtin_amdgcn_mfma_f32_32x32x16_bf16(wa, y0, a00, 0, 0, 0); a01 = __builtin_amdgcn_mfma_f32_32x32x16_bf16(wa, y1, a01, 0, 0, 0);
            a10 = __builtin_amdgcn_mfma_f32_32x32x16_bf16(wb, y0, a10, 0, 0, 0); a11 = __builtin_amdgcn_mfma_f32_32x32x16_bf16(wb, y1, a11, 0, 0, 0);
        }
        const int nvalid = meta ? NMETA : 64;
#pragma unroll
        for (int tt = 0; tt < 2; ++tt) {
            const int t = 32 * tt + r32;
            if (t < nvalid) {
#pragma unroll
                for (int q = 0; q < 4; ++q) {
                    float v[4];
#pragma unroll
                    for (int e = 0; e < 4; ++e) { const float a = tt ? a01[4 * q + e] : a00[4 * q + e], gte = tt ? a11[4 * q + e] : a10[4 * q + e];
                        v[e] = a * __builtin_amdgcn_rcpf(1.0f + __builtin_amdgcn_exp2f(-gte * LOG2E)); }
                    u32x2 w; w.x = cvtpk(v[0], v[1]); w.y = cvtpk(v[2], v[3]);
                    *(u32x2*)(mix + (size_t)(row0 + t) * D + 32 * wid + 8 * q + 4 * hi) = w;
                }
            }
        }
        __syncthreads();
    }
}
__device__ __forceinline__ float wave_incl_scan(float v, int lane) {
#pragma unroll
    for (int o = 1; o < 64; o <<= 1) { const float t = __shfl_up(v, o); if (lane >= o) v += t; }
    return v;
}
__device__ __forceinline__ void cum_wave(int b, int h, const float* fg, float bias, float* cum, int lane) {
    float vm = 0.f; if (lane < NMETA) vm = log_sigmoid(fg[(size_t)(MAIN + lane) * 4 + h] + bias);
    const float cm = wave_incl_scan(vm, lane);
    const float tot_meta = __shfl(cm, 63);
    if (b == 0 && lane < NMETA) cum[(size_t)(MAIN + lane) * 4 + h] = cm * LOG2E;
    float f[32]; float s = 0.f;
#pragma unroll
    for (int i = 0; i < 32; ++i) { f[i] = log_sigmoid(fg[(size_t)(b * SEQ + 32 * lane + i) * 4 + h] + bias); s += f[i]; }
    const float inc = wave_incl_scan(s, lane);
    float run = tot_meta + (inc - s);
#pragma unroll
    for (int i = 0; i < 32; ++i) { run += f[i]; cum[(size_t)(b * SEQ + 32 * lane + i) * 4 + h] = run * LOG2E; }
}
}

__device__ __forceinline__ void router_block(int blk, const RowSrc& s, const float* g, const float* wr, bf16_t* hbuf, gu32* ecnt, int* list, int* tokinfo, LAS unsigned char* lds, int wave, int lane) {
    LAS int* wc = (LAS int*)lds;
    LAS int* bb = (LAS int*)(lds + 256);
    int e1s[8], e2s[8]; float g1s[8];
    int cnt[8];
#pragma unroll
    for (int e = 0; e < 8; ++e) cnt[e] = 0;
#pragma unroll
    for (int it = 0; it < 8; ++it) {
        const int r = blk * 64 + wave * 8 + it;
        unsigned long long* o8 = (unsigned long long*)(hbuf + (size_t)r * D) + lane;
        const float4* p = (const float4*)res_row(s, r) + lane;
        float4 v[4]; float ss = 0.f;
#pragma unroll
        for (int j = 0; j < 4; ++j) { v[j] = p[64 * j]; ss += v[j].x * v[j].x + v[j].y * v[j].y + v[j].z * v[j].z + v[j].w * v[j].w; }
        ss = wave_sum(ss);
        const float rstd = 1.0f / sqrtf(ss * (1.0f / D) + EPS);
        float a[8];
#pragma unroll
        for (int e = 0; e < 8; ++e) a[e] = 0.f;
#pragma unroll
        for (int j = 0; j < 4; ++j) {
            const float4 gj = ((const float4*)g)[lane + 64 * j];
            v[j].x = v[j].x * rstd * gj.x; v[j].y = v[j].y * rstd * gj.y; v[j].z = v[j].z * rstd * gj.z; v[j].w = v[j].w * rstd * gj.w;
            o8[64 * j] = (unsigned long long)cvtpk(v[j].x, v[j].y) | ((unsigned long long)cvtpk(v[j].z, v[j].w) << 32);
            const int k = 256 * j + 4 * lane;
            const float hv[4] = {v[j].x, v[j].y, v[j].z, v[j].w};
#pragma unroll
            for (int i = 0; i < 4; ++i) {
                const float4 w0 = *(const float4*)(wr + (size_t)(k + i) * 8), w1 = *(const float4*)(wr + (size_t)(k + i) * 8 + 4);
                a[0] += hv[i] * w0.x; a[1] += hv[i] * w0.y; a[2] += hv[i] * w0.z; a[3] += hv[i] * w0.w;
                a[4] += hv[i] * w1.x; a[5] += hv[i] * w1.y; a[6] += hv[i] * w1.z; a[7] += hv[i] * w1.w;
            }
        }
#pragma unroll
        for (int e = 0; e < 8; ++e) a[e] = wave_sum(a[e]);
        int i1 = 0; float v1 = a[0];
#pragma unroll
        for (int e = 1; e < 8; ++e) if (a[e] > v1) { v1 = a[e]; i1 = e; }
        int i2 = 0; float v2 = -3.0e38f;
#pragma unroll
        for (int e = 0; e < 8; ++e) if (e != i1 && a[e] > v2) { v2 = a[e]; i2 = e; }
        e1s[it] = i1; e2s[it] = i2; g1s[it] = 1.0f / (1.0f + expf(v2 - v1));
#pragma unroll
        for (int e = 0; e < 8; ++e) cnt[e] += (e == i1) + (e == i2);
    }
    if (lane < 8) { int c = 0;
#pragma unroll
        for (int e = 0; e < 8; ++e) if (lane == e) c = cnt[e];
        wc[wave * 8 + lane] = c; }
    LDS_WAIT(); __syncthreads();
    if (wave == 0 && lane < 8) { int tot = 0;
#pragma unroll
        for (int w = 0; w < 8; ++w) tot += wc[w * 8 + lane];
        bb[lane] = (int)__hip_atomic_fetch_add(ecnt + 64 * lane, (unsigned)tot, RLX_AGENT); }
    LDS_WAIT(); __syncthreads();
    int off[8];
#pragma unroll
    for (int e = 0; e < 8; ++e) { int o = bb[e]; for (int w = 0; w < 8; ++w) if (w < wave) o += wc[w * 8 + e]; off[e] = o; }
#pragma unroll
    for (int it = 0; it < 8; ++it) {
        const int r = blk * 64 + wave * 8 + it;
        int p1 = 0, p2 = 0;
#pragma unroll
        for (int e = 0; e < 8; ++e) { if (e == e1s[it]) { p1 = off[e]; off[e] += 1; } }
#pragma unroll
        for (int e = 0; e < 8; ++e) { if (e == e2s[it]) { p2 = off[e]; off[e] += 1; } }
        if (lane == 0) {
            list[e1s[it] * 16384 + p1] = r; list[e2s[it] * 16384 + p2] = r;
            int4 ti; ti.x = e1s[it] | (e2s[it] << 8); ti.y = p1; ti.z = p2; ti.w = (int)__float_as_uint(g1s[it]);
            *(int4*)(tokinfo + (size_t)r * 4) = ti;
        }
    }
    __syncthreads();
}

__device__ __forceinline__ RowSrc mk_src(const MkArgs& args, int layer0) {
    RowSrc s{}; s.x = argf(args, 0); s.meta = argf(args, 1); s.dout = argout(args); s.resm = (const float*)(argws(args) + W_RESM); s.layer0 = layer0; s.pad = 0; return s;
}
__global__ void __launch_bounds__(NWAVES * 64, 2) mk_fwd(MkArgs args) {
    extern __shared__ __attribute__((aligned(16))) unsigned char lds_raw[];
    LAS unsigned char* lds = (LAS unsigned char*)lds_raw;
    volatile LAS unsigned* MISC = (volatile LAS unsigned*)(lds + MISC_OFF);
    const int tid = threadIdx.x;
    const int G = gridDim.x, bx = blockIdx.x;
    const int vcu = (G % 8 == 0) ? (bx % 8) * (G / 8) + bx / 8 : bx;
    const int NGW = G * NWAVES;
    for (int u = tid; u < (LDS_BYTES - LDSCTL_OFF) / 4; u += NWAVES * 64) ((LAS unsigned*)(lds + LDSCTL_OFF))[u] = 0u;
    __syncthreads();
    (void)xcd_barrier_post((unsigned*)((gu32*)(argws(args) + W_CTL) + CW_BAR), MISC + 8);
#ifndef PH_MASK
#define PH_MASK 0x1FFFF
#endif
#define IN(k) (((PH_MASK >> (k)) & 1) && argi(args, 0) <= (k) && (k) < argi(args, 1))
#define SEAM(k) do { if (IN(k) && IN((k) + 1)) { XcdBarrier bar_; bar_.bar = (unsigned*)((gu32*)(argws(args) + W_CTL) + CW_BAR); bar_.x = xb_xcc_id(); bar_.st = (volatile LAS unsigned*)(lds + MISC_OFF) + 8; xcd_barrier(bar_); } } while (0)
#define WSP(T, off) ((T*)(argws(args) + (off)))
#define FRESH() int tid_f = threadIdx.x; asm volatile("" : "+v"(tid_f)); const int lane_f = tid_f & 63, wave_f = __builtin_amdgcn_readfirstlane(tid_f >> 6), gw_f = vcu * NWAVES + wave_f; (void)lane_f; (void)gw_f

    if (IN(0)) {
        FRESH();
        p0_prologue(args, lds, gw_f, NGW, wave_f, lane_f);
        norm_rows(mk_src(args, 1), argf(args, 2), argf(args, 3) + ZW, WSP(bf16_t, W_H), WSP(float, W_FG), gw_f, NGW, lane_f, MP);
    }
    SEAM(0);
#pragma unroll 1
    for (int l = 0; l < 2; ++l) {
        const int pb = 1 + 8 * l;
        if (IN(pb + 0)) {
            pg8::Gemm g{WSP(bf16_t, W_H), WSP(bf16_t, W_WIN) + (size_t)l * ZW * D, MP, ZW, D};
            pg8::StaticOrder S; S.init(MP, ZW, G, bx);
            pg8::EpiBf16<0> E{WSP(bf16_t, W_Z), ZW, nullptr, 0, 0, 1.f};
            pg8::gemm_phase<pg8::EpiBf16<0>, pg8::StaticOrder, true, true>(lds, g, S, E);
        }
        SEAM(pb + 0);
        if (IN(pb + 1)) {
            if (!(argi(args, 2) & 1)) for (int u = bx; u < 257; u += G)
                ssm::ssm_unit<false>(l, u < 256 ? u / 32 : NB, u % 32, WSP(bf16_t, W_Z), argws(args) + W_TAB, WSP(float2, W_TAB + T_S), WSP(float2, W_TAB + T_SMETA), nullptr, nullptr, nullptr, (char*)lds_raw);
            { FRESH(); if (wave_f < 4) for (int b = bx; b < NB; b += G) ssm::cum_wave(b, wave_f, WSP(float, W_FG), argf(args, 19)[l * 4 + wave_f], WSP(float, W_CUM), lane_f); }
        }
        SEAM(pb + 1);
        if (IN(pb + 2)) {
#ifndef NO_SSMC
            if (!(argi(args, 2) & 1))
                for (int u = bx; u < 257; u += G)
                    ssm::ssm_unit<true>(l, u < 256 ? u / 32 : NB, u % 32, WSP(bf16_t, W_Z), argws(args) + W_TAB, WSP(float2, W_TAB + T_S), WSP(float2, W_TAB + T_SMETA), argf(args, 12) + l * 256,
                                        WSP(bf16_t, W_WGLU) + (size_t)l * 512 * 256, WSP(bf16_t, W_MIX), (char*)lds_raw);
#endif
            if (!(argi(args, 2) & 2)) {
                gu32* ctl = (gu32*)(argws(args) + W_CTL);
#ifndef NO_ATTD
                for (;;) {
                    if (tid == 0) MISC[16] = __hip_atomic_fetch_add(ctl + CW_QCTR + 64 * (2 * l), 1u, RLX_AGENT);
                    __syncthreads();
                    const int u = (int)MISC[16];
                    __syncthreads();
                    if (u >= 516) break;
                    const int i = u < 512 ? 15 - (u >> 5) : 0, w = u & 31;
                    const float* lamp = WSP(float, W_TAB + T_LAM);
                    att::attn_unit<false>(w & 3, u < 512 ? (w >> 2) : NB, i, WSP(bf16_t, W_Z), WSP(float, W_CUM), lamp[2 * l], lamp[2 * l + 1], argf(args, 18) + l * 128, WSP(bf16_t, W_MIX), (char*)lds_raw);
                }
#endif
#ifndef NO_ATTF
                for (;;) {
                    if (tid == 0) MISC[17] = __hip_atomic_fetch_add(ctl + CW_QCTR + 64 * (2 * l + 1), 1u, RLX_AGENT);
                    __syncthreads();
                    const int u = (int)MISC[17];
                    __syncthreads();
                    if (u >= 258) break;
                    const int i = u < 256 ? 15 - (u >> 4) : 0, w = u & 15;
                    att::attn_unit<true>(w & 1, u < 256 ? (w >> 1) : NB, i, WSP(bf16_t, W_Z), WSP(float, W_CUM), 0.f, 0.f, nullptr, WSP(bf16_t, W_MIX), (char*)lds_raw);
                }
#endif
            }
        }
        SEAM(pb + 2);
        if (IN(pb + 3)) {
            const int Mrows = (l == 0) ? MP : MAIN;
            pg8::Gemm g{WSP(bf16_t, W_MIX), WSP(bf16_t, W_WOUT) + (size_t)l * D * D, Mrows, D, D};
            pg8::StaticOrder S; S.init(Mrows, D, G, bx);
            pg8::EpiResF32 E{mk_src(args, l == 0), argout(args), WSP(float, W_RESM)};
            pg8::gemm_phase<pg8::EpiResF32, pg8::StaticOrder, true, true>(lds, g, S, E);
        }
        SEAM(pb + 3);
        if (l == 0) {
            if (IN(pb + 4)) { FRESH(); norm_rows(mk_src(args, 0), argf(args, 20), nullptr, WSP(bf16_t, W_H), nullptr, gw_f, NGW, lane_f, MP); }
            SEAM(pb + 4);
            if (IN(pb + 5)) {
                pg8::Gemm g{WSP(bf16_t, W_H), WSP(bf16_t, W_W13), MP, 2 * FFD, D};
                pg8::StaticOrder S; S.init(MP, 2 * FFD, G, bx);
                pg8::EpiSwiglu E{WSP(bf16_t, W_HD), FFD, 0};
                pg8::gemm_phase<pg8::EpiSwiglu, pg8::StaticOrder, true, true>(lds, g, S, E);
            }
            SEAM(pb + 5);
            if (IN(pb + 6)) {
                pg8::Gemm g{WSP(bf16_t, W_HD), WSP(bf16_t, W_W2), MP, D, FFD};
                pg8::StaticOrder S; S.init(MP, D, G, bx);
                pg8::EpiResF32 E{mk_src(args, 0), argout(args), WSP(float, W_RESM)};
                pg8::gemm_phase<pg8::EpiResF32, pg8::StaticOrder, true, true>(lds, g, S, E);
            }
            SEAM(pb + 6);
            if (IN(pb + 7)) { FRESH(); norm_rows(mk_src(args, 0), argf(args, 2) + D, argf(args, 3) + (size_t)D * INW + ZW, WSP(bf16_t, W_H), WSP(float, W_FG), gw_f, NGW, lane_f, MP); }
            SEAM(pb + 7);
        } else {
            if (IN(pb + 4)) { FRESH(); for (int blk = bx; blk < MAIN / 64; blk += G) router_block(blk, mk_src(args, 0), argf(args, 20) + D, argf(args, 24), WSP(bf16_t, W_H), (gu32*)(argws(args) + W_CTL) + CW_ECNT, WSP(int, W_LIST), WSP(int, W_TOK), lds, wave_f, lane_f); }
            SEAM(pb + 4);
            if (IN(pb + 5)) {
                pg8::MoeOrder<true> S; const int P = S.setup((gu32*)(argws(args) + W_CTL) + CW_ECNT);
                pg8::Gemm g{WSP(bf16_t, W_H), WSP(bf16_t, W_WE13), P * 256, 2 * FFE, D};
                S.init(P * 256, 2 * FFE, G, bx); S.estride = (size_t)2 * FFE * D * 2; S.list = WSP(int, W_LIST);
                pg8::EpiSwiglu E{WSP(bf16_t, W_HM), FFE, 0};
                pg8::gemm_phase<pg8::EpiSwiglu, pg8::MoeOrder<true>, true, true>(lds, g, S, E);
            }
            SEAM(pb + 5);
            if (IN(pb + 6)) {
                pg8::MoeOrder<false> S; const int P = S.setup((gu32*)(argws(args) + W_CTL) + CW_ECNT);
                pg8::Gemm g{WSP(bf16_t, W_HM), WSP(bf16_t, W_WE2), P * 256, D, FFE};
                S.init(P * 256, D, G, bx); S.estride = (size_t)D * FFE * 2; S.list = WSP(int, W_LIST);
                pg8::EpiBf16<0> E{WSP(bf16_t, W_YM), D, nullptr, 0, 0, 1.f};
                pg8::gemm_phase<pg8::EpiBf16<0>, pg8::MoeOrder<false>, true, true>(lds, g, S, E);
            }
            SEAM(pb + 6);
            if (IN(pb + 7)) {
                FRESH(); const int gw = gw_f, lane = lane_f;
                pg8::MoeOrder<false> S; (void)S.setup((gu32*)(argws(args) + W_CTL) + CW_ECNT);
                const bf16_t* Y = WSP(bf16_t, W_YM); const float* gf = argf(args, 28); const int* tokinfo = WSP(int, W_TOK); float* dout = argout(args);
                for (int r = gw; r < MAIN; r += NGW) {
                    const int4 ti = *(const int4*)(tokinfo + (size_t)r * 4);
                    const int e1 = ti.x & 255, e2 = (ti.x >> 8) & 255; const float g1 = __uint_as_float((unsigned)ti.w), g2 = 1.0f - g1;
                    const int s1 = S.pbase_of(e1) * 256 + ti.y, s2 = S.pbase_of(e2) * 256 + ti.z;
                    float4* p = (float4*)(dout + (size_t)r * D) + lane;
                    const u32x2* y1 = (const u32x2*)(Y + (size_t)s1 * D) + lane; const u32x2* y2 = (const u32x2*)(Y + (size_t)s2 * D) + lane;
                    float4 v[4]; float ss = 0.f;
#pragma unroll
                    for (int j = 0; j < 4; ++j) { v[j] = p[64 * j]; const u32x2 a = y1[64 * j], b = y2[64 * j];
                        v[j].x += g1 * __uint_as_float(a.x << 16) + g2 * __uint_as_float(b.x << 16);
                        v[j].y += g1 * __uint_as_float(a.x & 0xffff0000u) + g2 * __uint_as_float(b.x & 0xffff0000u);
                        v[j].z += g1 * __uint_as_float(a.y << 16) + g2 * __uint_as_float(b.y << 16);
                        v[j].w += g1 * __uint_as_float(a.y & 0xffff0000u) + g2 * __uint_as_float(b.y & 0xffff0000u);
                        ss += v[j].x * v[j].x + v[j].y * v[j].y + v[j].z * v[j].z + v[j].w * v[j].w; }
                    ss = wave_sum(ss);
                    const float rstd = 1.0f / sqrtf(ss * (1.0f / D) + EPS);
#pragma unroll
                    for (int j = 0; j < 4; ++j) { const float4 gj = ((const float4*)gf)[lane + 64 * j];
                        p[64 * j] = make_float4(v[j].x * rstd * gj.x, v[j].y * rstd * gj.y, v[j].z * rstd * gj.z, v[j].w * rstd * gj.w); }
                }
            }
        }
    }
#undef IN
#undef SEAM
#undef WSP
}

#ifndef OPT_MASK
#define OPT_MASK 0x3FF
#endif
#ifndef ONE_LAUNCH
#define ONE_LAUNCH 1
#endif
extern "C" void kernel_launch(void* const* d_in, const int* in_sizes, int n_in, void* d_out, int out_size, void* d_ws, size_t ws_size, hipStream_t stream) {
    static int grid = 0;
    if (grid == 0) {
        int dev = 0, cus = 0;
        if (n_in != 29 || out_size != MAIN * D || ws_size < W_END) { fprintf(stderr, "kernel_launch: unexpected shapes (n_in %d out %d ws %zu)\n", n_in, out_size, ws_size); grid = -1; return; }
        if (hipGetDevice(&dev) != hipSuccess || hipDeviceGetAttribute(&cus, hipDeviceAttributeMultiprocessorCount, dev) != hipSuccess) { grid = -1; return; }
        if (hipFuncSetAttribute((const void*)mk_fwd, hipFuncAttributeMaxDynamicSharedMemorySize, LDS_BYTES) != hipSuccess) { grid = -1; return; }
        int per_cu = 0;
        if (hipOccupancyMaxActiveBlocksPerMultiprocessor(&per_cu, (const void*)mk_fwd, NWAVES * 64, LDS_BYTES) != hipSuccess || per_cu < 1) fprintf(stderr, "kernel_launch: occupancy query says %d\n", per_cu);
        (void)hipGetLastError();
        grid = cus;
    }
    if (grid < 0) return;
    char* ws = (char*)d_ws; float* dout = (float*)d_out;
    (void)hipMemsetAsync(ws + W_CTL, 0, CTL_ZERO_BYTES, stream);
    MkArgs base{};
    for (int i = 0; i < 29; ++i) base.p[i] = d_in[i];
    base.p[29] = d_out; base.p[30] = d_ws; base.ph_lo = 0; base.ph_hi = 17; base.flags = 0; base.pad = 0;
    auto PH = [&](int lo, int hi, int flags) { MkArgs a = base; a.ph_lo = lo; a.ph_hi = hi; a.flags = flags; hipLaunchKernelGGL(mk_fwd, dim3(grid), dim3(NWAVES * 64), LDS_BYTES, stream, a); };
#if ONE_LAUNCH
    PH(0, 17, 0);
#else
    const float* x = (const float*)d_in[0]; const float* meta = (const float*)d_in[1];
    const float* w_in = (const float*)d_in[3]; const float* w_out = (const float*)d_in[4];
    const float* lam_re = (const float*)d_in[5]; const float* lam_im = (const float*)d_in[6]; const float* log_dt = (const float*)d_in[7];
    const float* b_re = (const float*)d_in[8]; const float* b_im = (const float*)d_in[9]; const float* c_re = (const float*)d_in[10]; const float* c_im = (const float*)d_in[11];
    const float* ssm_d = (const float*)d_in[12]; const float* w_glu = (const float*)d_in[13];
    const float* subln_g = (const float*)d_in[18]; const float* fox_b = (const float*)d_in[19]; const float* norm_ffn_g = (const float*)d_in[20];
    const float* dw1 = (const float*)d_in[21]; const float* dw3 = (const float*)d_in[22]; const float* dw2 = (const float*)d_in[23];
    const float* wrt = (const float*)d_in[24]; const float* mw1 = (const float*)d_in[25]; const float* mw3 = (const float*)d_in[26]; const float* mw2 = (const float*)d_in[27];
    const float* final_g = (const float*)d_in[28];
    bf16_t* hbuf = (bf16_t*)(ws + W_H); bf16_t* zbuf = (bf16_t*)(ws + W_Z); bf16_t* mix = (bf16_t*)(ws + W_MIX);
    float* resm = (float*)(ws + W_RESM); float* fgb = (float*)(ws + W_FG); float* cum = (float*)(ws + W_CUM); float* gates = (float*)(ws + W_TOK);
    bf16_t* ybuf = (bf16_t*)(ws + W_H);
    const float* lamp = (const float*)(ws + W_TAB + T_LAM);
    const int MG = 16512;
    PH(0, 1, 0);
    for (int l = 0; l < 2; ++l) {
        const int pb = 1 + 8 * l, bits = (OPT_MASK >> (5 * l)) & 31;
        const bool o_in = bits & 1, o_ssm = bits & 2, o_att = bits & 4, o_out = bits & 8, o_ffn = bits & 16;
        RowSrc src{}; src.x = x; src.meta = meta; src.dout = dout; src.resm = resm; src.layer0 = (l == 0); src.pad = 0;
        RowSrc cur{}; cur.x = x; cur.meta = meta; cur.dout = dout; cur.resm = resm; cur.layer0 = 0; cur.pad = 0;
        const float* w_in_l = w_in + (size_t)l * D * INW;
        if (o_in) PH(pb, pb + 1, 0);
        else hipLaunchKernelGGL((k_gemm<EpiZ, false>), dim3(1024), dim3(512), 0, stream, (const bf16_t*)hbuf, D, w_in_l, (const float*)nullptr, INW, MG, ZW, D, EpiZ{zbuf});
        const int fl = (o_ssm ? 0 : 1) | (o_att ? 0 : 2);
        PH(pb + 1, pb + 2, fl);
        if (!o_ssm) {
            hipLaunchKernelGGL(k_ssm_naive, dim3(NB * 16), dim3(64), 0, stream, (const bf16_t*)zbuf, lam_re + l * 1024, lam_im + l * 1024, log_dt + l * 16,
                               b_re + (size_t)l * 16384, b_im + (size_t)l * 16384, c_re + (size_t)l * 16384, c_im + (size_t)l * 16384, ssm_d + l * 256, ybuf);
            hipLaunchKernelGGL((k_gemm<EpiGlu, true>), dim3(1024), dim3(512), 0, stream, (const bf16_t*)ybuf, 256, w_glu + (size_t)l * 256 * 512, w_glu + (size_t)l * 256 * 512 + 256, 512, MG, 256, 256, EpiGlu{mix});
        }
        if (!o_att) hipLaunchKernelGGL(k_attn_naive_l, dim3(4096), dim3(256), 0, stream, (const bf16_t*)zbuf, (const float*)cum, (const float*)(lamp + 2 * l), subln_g + l * 128, mix);
        if (o_ssm || o_att) PH(pb + 2, pb + 3, fl);
        if (o_out) PH(pb + 3, pb + 4, 0);
        else hipLaunchKernelGGL((k_gemm<EpiRes, false>), dim3(1024), dim3(512), 0, stream, (const bf16_t*)mix, D, w_out + (size_t)l * D * D, (const float*)nullptr, D, MG, D, D, EpiRes{src, dout, resm});
        if (l == 0) {
            PH(pb + 4, pb + 5, 0);
            if (o_ffn) { PH(pb + 5, pb + 6, 0); PH(pb + 6, pb + 7, 0); }
            else {
                bf16_t* hn = (bf16_t*)(ws + W_HD);
                hipLaunchKernelGGL((k_gemm<EpiSwiglu, true>), dim3(1024), dim3(512), 0, stream, (const bf16_t*)hbuf, D, dw1, dw3, FFD, MG, FFD, D, EpiSwiglu{hn, FFD, 0});
                hipLaunchKernelGGL((k_gemm<EpiRes, false>), dim3(1024), dim3(512), 0, stream, (const bf16_t*)hn, FFD, dw2, (const float*)nullptr, D, MG, D, FFD, EpiRes{cur, dout, resm});
            }
            PH(pb + 7, pb + 8, 0);
        } else {
            if (o_ffn) { PH(pb + 4, pb + 5, 0); PH(pb + 5, pb + 6, 0); PH(pb + 6, pb + 7, 0); PH(pb + 7, pb + 8, 0); }
            else {
                bf16_t* hn = (bf16_t*)(ws + W_HM);
                hipLaunchKernelGGL(k_norm, dim3(1024), dim3(256), 0, stream, cur, norm_ffn_g + D, (const float*)nullptr, hbuf, fgb, wrt, gates);
                for (int e = 0; e < NE; ++e) {
                    hipLaunchKernelGGL((k_gemm<EpiSwiglu, true>), dim3(1024), dim3(512), 0, stream, (const bf16_t*)hbuf, D, mw1 + (size_t)e * D * FFE, mw3 + (size_t)e * D * FFE, FFE, MAIN, FFE, D, EpiSwiglu{hn, FFE, 0});
                    hipLaunchKernelGGL((k_gemm<EpiMoeDown, false>), dim3(1024), dim3(512), 0, stream, (const bf16_t*)hn, FFE, mw2 + (size_t)e * FFE * D, (const float*)nullptr, D, MAIN, D, FFE, EpiMoeDown{gates, dout, e, 0});
                }
                hipLaunchKernelGGL(k_final, dim3(1024), dim3(256), 0, stream, dout, final_g);
            }
        }
    }
#endif
}
```

```cpp
#include <hip/hip_runtime.h>
#include <stdint.h>

typedef unsigned short bf16_t;

constexpr int D = 1024, NB = 8, SEQ = 2048, NMETA = 16;
constexpr int MAIN = NB * SEQ;
constexpr int MVALID = MAIN + NMETA;
constexpr int MP = 16640;
constexpr int ZW = 2560, INW = 2564;
constexpr int C_DQ = 256, C_DK = 768, C_DV = 1280, C_FQ = 1792, C_FK = 2048, C_FV = 2304;
constexpr int FFD = 2816, FFE = 3584, NE = 8;
constexpr float EPS = 1e-6f;
constexpr float LOG2E = 1.4426950408889634f;
constexpr float QSCALE = 0.125f * LOG2E;

constexpr size_t MiB = 1u << 20;
__device__ __forceinline__ float bf2f(bf16_t v) { return __uint_as_float(((unsigned)v) << 16); }
__device__ __forceinline__ bf16_t f2bf(float f) { unsigned u = __float_as_uint(f); return (bf16_t)((u + 0x7fffu + ((u >> 16) & 1u)) >> 16); }
__device__ __forceinline__ float wave_sum(float v) {
#pragma unroll
    for (int o = 32; o > 0; o >>= 1) v += __shfl_xor(v, o);
    return v;
}
__device__ __forceinline__ float wave_max(float v) {
#pragma unroll
    for (int o = 32; o > 0; o >>= 1) v = fmaxf(v, __shfl_xor(v, o));
    return v;
}

struct RowSrc { const float* x; const float* meta; const float* dout; const float* resm; int layer0; int pad; };
__device__ __forceinline__ const float* res_row(const RowSrc& s, int r) {
    if (s.layer0) { int mr = r - MAIN; if (mr > NMETA - 1) mr = NMETA - 1; return r < MAIN ? s.x + (size_t)r * D : s.meta + (size_t)mr * D; }
    return r < MAIN ? s.dout + (size_t)r * D : s.resm + (size_t)(r - MAIN) * D;
}

__global__ __launch_bounds__(256) void k_norm(RowSrc s, const float* __restrict__ g, const float* __restrict__ wfg  ,
                                              bf16_t* __restrict__ hbuf, float* __restrict__ fgbuf,
                                              const float* __restrict__ wr  , float* __restrict__ gates) {
    const int lane = threadIdx.x & 63;
    const int gw = (blockIdx.x * blockDim.x + threadIdx.x) >> 6, nw = (gridDim.x * blockDim.x) >> 6;
    for (int r = gw; r < MP; r += nw) {
        unsigned long long* o8 = (unsigned long long*)(hbuf + (size_t)r * D) + lane;
        if (r >= MVALID) {
#pragma unroll
            for (int j = 0; j < 4; ++j) o8[64 * j] = 0ull;
            continue;
        }
        const float4* p = (const float4*)res_row(s, r) + lane;
        float4 v[4]; float ss = 0.f;
#pragma unroll
        for (int j = 0; j < 4; ++j) { v[j] = p[64 * j]; ss += v[j].x * v[j].x + v[j].y * v[j].y + v[j].z * v[j].z + v[j].w * v[j].w; }
        ss = wave_sum(ss);
        const float rstd = 1.0f / sqrtf(ss * (1.0f / D) + EPS);
#pragma unroll
        for (int j = 0; j < 4; ++j) {
            const float4 gj = ((const float4*)g)[lane + 64 * j];
            v[j].x = v[j].x * rstd * gj.x; v[j].y = v[j].y * rstd * gj.y; v[j].z = v[j].z * rstd * gj.z; v[j].w = v[j].w * rstd * gj.w;
            o8[64 * j] = (unsigned long long)f2bf(v[j].x) | ((unsigned long long)f2bf(v[j].y) << 16) | ((unsigned long long)f2bf(v[j].z) << 32) | ((unsigned long long)f2bf(v[j].w) << 48);
        }
        if (wfg) {
            float a[4] = {0.f, 0.f, 0.f, 0.f};
#pragma unroll
            for (int j = 0; j < 4; ++j) {
                const int k = 256 * j + 4 * lane;
                const float hv[4] = {v[j].x, v[j].y, v[j].z, v[j].w};
#pragma unroll
                for (int i = 0; i < 4; ++i) {
                    const float4 w = *(const float4*)(wfg + (size_t)(k + i) * INW);
                    a[0] += hv[i] * w.x; a[1] += hv[i] * w.y; a[2] += hv[i] * w.z; a[3] += hv[i] * w.w;
                }
            }
#pragma unroll
            for (int c = 0; c < 4; ++c) a[c] = wave_sum(a[c]);
            if (lane == 0) *(float4*)(fgbuf + (size_t)r * 4) = make_float4(a[0], a[1], a[2], a[3]);
        }
        if (wr && r < MAIN) {
            float a[8];
#pragma unroll
            for (int e = 0; e < 8; ++e) a[e] = 0.f;
#pragma unroll
            for (int j = 0; j < 4; ++j) {
                const int k = 256 * j + 4 * lane;
                const float hv[4] = {v[j].x, v[j].y, v[j].z, v[j].w};
#pragma unroll
                for (int i = 0; i < 4; ++i) {
                    const float4 w0 = *(const float4*)(wr + (size_t)(k + i) * 8), w1 = *(const float4*)(wr + (size_t)(k + i) * 8 + 4);
                    a[0] += hv[i] * w0.x; a[1] += hv[i] * w0.y; a[2] += hv[i] * w0.z; a[3] += hv[i] * w0.w;
                    a[4] += hv[i] * w1.x; a[5] += hv[i] * w1.y; a[6] += hv[i] * w1.z; a[7] += hv[i] * w1.w;
                }
            }
#pragma unroll
            for (int e = 0; e < 8; ++e) a[e] = wave_sum(a[e]);
            int i1 = 0; float v1 = a[0];
#pragma unroll
            for (int e = 1; e < 8; ++e) if (a[e] > v1) { v1 = a[e]; i1 = e; }
            int i2 = -1; float v2 = -3.0e38f;
#pragma unroll
            for (int e = 0; e < 8; ++e) if (e != i1 && a[e] > v2) { v2 = a[e]; i2 = e; }
            const float g1 = 1.0f / (1.0f + expf(v2 - v1)), g2 = 1.0f - g1;
            if (lane < 8) gates[(size_t)r * 8 + lane] = lane == i1 ? g1 : (lane == i2 ? g2 : 0.f);
        }
    }
}

__device__ __forceinline__ float log_sigmoid(float x) { return fminf(x, 0.f) - log1pf(expf(-fabsf(x))); }
__global__ void k_cum(const float* __restrict__ fg, const float* __restrict__ bias, float* __restrict__ cum) {
    const int t = blockIdx.x * blockDim.x + threadIdx.x;
    if (t >= NB * 4) return;
    const int b = t >> 2, h = t & 3; const float bi = bias[h];
    float c = 0.f;
    for (int j = 0; j < NMETA; ++j) { c += log_sigmoid(fg[(size_t)(MAIN + j) * 4 + h] + bi); if (b == 0) cum[(size_t)(MAIN + j) * 4 + h] = c * LOG2E; }
    for (int t0 = 0; t0 < SEQ; t0 += 16) {
        float f[16];
#pragma unroll
        for (int i = 0; i < 16; ++i) f[i] = fg[(size_t)(b * SEQ + t0 + i) * 4 + h];
#pragma unroll
        for (int i = 0; i < 16; ++i) { c += log_sigmoid(f[i] + bi); cum[(size_t)(b * SEQ + t0 + i) * 4 + h] = c * LOG2E; }
    }
}

template <class Epi, bool DUAL>
__global__ __launch_bounds__(512) void k_gemm(const bf16_t* __restrict__ A, int lda, const float* __restrict__ W1, const float* __restrict__ W2, int ldw,
                                              int M, int N, int K, Epi epi) {
    __shared__ float As[16][132];
    __shared__ float B1s[16][132];
    __shared__ float B2s[DUAL ? 16 : 1][132];
    const int tid = threadIdx.x, tx = tid & 15, ty = tid >> 4;
    const int ntm = M / 128, ntn = N / 128;
    for (int tile = blockIdx.x; tile < ntm * ntn; tile += gridDim.x) {
        const int tm = tile / ntn, tn = tile % ntn, m0 = tm * 128, n0 = tn * 128;
        float acc1[4][8], acc2[4][8];
#pragma unroll
        for (int i = 0; i < 4; ++i)
#pragma unroll
            for (int j = 0; j < 8; ++j) { acc1[i][j] = 0.f; acc2[i][j] = 0.f; }
        for (int k0 = 0; k0 < K; k0 += 16) {
            {
                const int row = tid >> 2, kq = tid & 3;
                const uint2 av = *(const uint2*)(A + (size_t)(m0 + row) * lda + k0 + 4 * kq);
                As[4 * kq + 0][row] = __uint_as_float(av.x << 16); As[4 * kq + 1][row] = __uint_as_float(av.x & 0xffff0000u);
                As[4 * kq + 2][row] = __uint_as_float(av.y << 16); As[4 * kq + 3][row] = __uint_as_float(av.y & 0xffff0000u);
                const int kk = tid >> 5, nq = tid & 31;
                const float4 b1 = *(const float4*)(W1 + (size_t)(k0 + kk) * ldw + n0 + 4 * nq);
                *(float4*)&B1s[kk][4 * nq] = b1;
                if (DUAL) { const float4 b2 = *(const float4*)(W2 + (size_t)(k0 + kk) * ldw + n0 + 4 * nq); *(float4*)&B2s[kk][4 * nq] = b2; }
            }
            __syncthreads();
#pragma unroll
            for (int kk = 0; kk < 16; ++kk) {
                const float4 a4 = *(const float4*)&As[kk][ty * 4];
                const float a[4] = {a4.x, a4.y, a4.z, a4.w};
                const float4 b0 = *(const float4*)&B1s[kk][tx * 8], b1 = *(const float4*)&B1s[kk][tx * 8 + 4];
                const float b[8] = {b0.x, b0.y, b0.z, b0.w, b1.x, b1.y, b1.z, b1.w};
#pragma unroll
                for (int i = 0; i < 4; ++i)
#pragma unroll
                    for (int j = 0; j < 8; ++j) acc1[i][j] += a[i] * b[j];
                if (DUAL) {
                    const float4 c0 = *(const float4*)&B2s[kk][tx * 8], c1 = *(const float4*)&B2s[kk][tx * 8 + 4];
                    const float c[8] = {c0.x, c0.y, c0.z, c0.w, c1.x, c1.y, c1.z, c1.w};
#pragma unroll
                    for (int i = 0; i < 4; ++i)
#pragma unroll
                        for (int j = 0; j < 8; ++j) acc2[i][j] += a[i] * c[j];
                }
            }
            __syncthreads();
        }
#pragma unroll
        for (int i = 0; i < 4; ++i)
#pragma unroll
            for (int j = 0; j < 8; ++j) epi(m0 + ty * 4 + i, n0 + tx * 8 + j, acc1[i][j], acc2[i][j]);
    }
}
struct EpiZ { bf16_t* z; __device__ void operator()(int m, int n, float a, float) const {
    const float sc = ((n >= C_DQ && n < C_DK) || (n >= C_FQ && n < C_FK)) ? QSCALE : 1.0f; z[(size_t)m * ZW + n] = f2bf(a * sc); } };
struct EpiRes { RowSrc src; float* dout; float* resm; __device__ void operator()(int m, int n, float a, float) const {
    const float base = res_row(src, m)[n]; float* o = m < MAIN ? dout + (size_t)m * D : resm + (size_t)(m - MAIN) * D; o[n] = base + a; } };
struct EpiSwiglu { bf16_t* h; int ldh; int pad; __device__ void operator()(int m, int n, float a, float b) const { h[(size_t)m * ldh + n] = f2bf(a / (1.0f + expf(-a)) * b); } };
struct EpiGlu { bf16_t* mix; __device__ void operator()(int m, int n, float a, float b) const { mix[(size_t)m * D + n] = f2bf(a / (1.0f + expf(-b))); } };
struct EpiMoeDown { const float* gates; float* dout; int e; int pad; __device__ void operator()(int m, int n, float a, float) const { dout[(size_t)m * D + n] += gates[(size_t)m * 8 + e] * a; } };

__device__ __forceinline__ double exp_small(double x) {
    const double y = x * (1.0 / 1024.0); double t = 1.0, s = 1.0;
#pragma unroll
    for (int i = 1; i <= 10; ++i) { t = t * y / (double)i; s += t; }
#pragma unroll
    for (int i = 0; i < 10; ++i) s = s * s;
    return s;
}
__device__ __forceinline__ void sincos_d(double x, double& sn, double& cs) {
    const double TWO_PI = 6.283185307179586476925;
    const double k = rint(x / TWO_PI); const double r = x - k * TWO_PI, r2 = r * r;
    double ts = r, tc = 1.0; sn = r; cs = 1.0;
#pragma unroll
    for (int i = 1; i <= 15; ++i) { tc = -tc * r2 / (double)((2 * i - 1) * (2 * i)); cs += tc; ts = -ts * r2 / (double)((2 * i) * (2 * i + 1)); sn += ts; }
}
__device__ __forceinline__ void ssm_consts(const float* lam_re, const float* lam_im, const float* log_dt, int g, int n, float& are, float& aim, float& cre, float& cim) {
    const double dt = exp_small((double)log_dt[g]);
    const double lr = (double)lam_re[g * 64 + n], li = (double)lam_im[g * 64 + n];
    const double mag = exp_small(lr * dt); double sn, cs; sincos_d(li * dt, sn, cs);
    const double ar = mag * cs, ai = mag * sn, den = lr * lr + li * li, nr = ar - 1.0, ni = ai;
    are = (float)ar; aim = (float)ai; cre = (float)((nr * lr + ni * li) / den); cim = (float)((ni * lr - nr * li) / den);
}
__device__ __forceinline__ float gelu_tanh(float x) { return 0.5f * x * (1.0f + tanhf(0.7978845608028654f * (x + 0.044715f * x * x * x))); }
__global__ __launch_bounds__(64) void k_ssm_naive(const bf16_t* __restrict__ z, const float* lam_re, const float* lam_im, const float* log_dt,
                                                  const float* __restrict__ b_re, const float* __restrict__ b_im, const float* __restrict__ c_re, const float* __restrict__ c_im,
                                                  const float* __restrict__ dsk, bf16_t* __restrict__ ybuf) {
    __shared__ float2 xs[64];
    const int n = threadIdx.x, g = blockIdx.x & 15, b = blockIdx.x >> 4;
    float are, aim, cre, cim; ssm_consts(lam_re, lam_im, log_dt, g, n, are, aim, cre, cim);
    float br[16], bi[16];
#pragma unroll
    for (int c = 0; c < 16; ++c) { const float r = b_re[(g * 64 + n) * 16 + c], i = b_im[(g * 64 + n) * 16 + c]; br[c] = cre * r - cim * i; bi[c] = cre * i + cim * r; }
    float xr = 0.f, xi = 0.f;
    for (int s = 0; s < NMETA + SEQ; ++s) {
        const int row = s < NMETA ? MAIN + s : b * SEQ + (s - NMETA);
        const uint4 u0 = *(const uint4*)(z + (size_t)row * ZW + 16 * g), u1 = *(const uint4*)(z + (size_t)row * ZW + 16 * g + 8);
        const unsigned uw[8] = {u0.x, u0.y, u0.z, u0.w, u1.x, u1.y, u1.z, u1.w};
        float pr = 0.f, pi = 0.f;
#pragma unroll
        for (int c = 0; c < 8; ++c) { const float lo = __uint_as_float(uw[c] << 16), hi = __uint_as_float(uw[c] & 0xffff0000u);
            pr += lo * br[2 * c] + hi * br[2 * c + 1]; pi += lo * bi[2 * c] + hi * bi[2 * c + 1]; }
        const float nxr = are * xr - aim * xi + pr, nxi = are * xi + aim * xr + pi; xr = nxr; xi = nxi;
        xs[n] = make_float2(xr, xi);
        __syncthreads();
        if (n < 16 && (s >= NMETA || b == 0)) {
            const float* cr = c_re + (g * 16 + n) * 64; const float* ci = c_im + (g * 16 + n) * 64; float y = 0.f;
            for (int m = 0; m < 64; ++m) y += xs[m].x * cr[m] - xs[m].y * ci[m];
            y += dsk[g * 16 + n] * bf2f(z[(size_t)row * ZW + 16 * g + n]);
            ybuf[(size_t)row * 256 + 16 * g + n] = f2bf(gelu_tanh(y));
        }
        __syncthreads();
    }
}

__device__ __forceinline__ void attn_map(const bf16_t* __restrict__ z, const float* __restrict__ cum, int r, int b, int nk, int qcol, int kcol, int vcol, bool two_v, int bias_h,
                                         float* sc, int lane, float& o0, float& o1) {
    float q[64];
    {
        const uint4* qp = (const uint4*)(z + (size_t)r * ZW + qcol);
#pragma unroll
        for (int i = 0; i < 8; ++i) { const uint4 w = qp[i]; const unsigned ww[4] = {w.x, w.y, w.z, w.w};
#pragma unroll
            for (int j = 0; j < 4; ++j) { q[8 * i + 2 * j] = __uint_as_float(ww[j] << 16); q[8 * i + 2 * j + 1] = __uint_as_float(ww[j] & 0xffff0000u); } }
    }
    const float cq = bias_h >= 0 ? cum[(size_t)r * 4 + bias_h] : 0.f;
    float mx = -3.0e38f;
    for (int k = lane; k < nk; k += 64) {
        const int kr = k < NMETA ? MAIN + k : b * SEQ + (k - NMETA);
        const uint4* kp = (const uint4*)(z + (size_t)kr * ZW + kcol);
        float s = 0.f;
#pragma unroll
        for (int i = 0; i < 8; ++i) { const uint4 w = kp[i]; const unsigned ww[4] = {w.x, w.y, w.z, w.w};
#pragma unroll
            for (int j = 0; j < 4; ++j) s += q[8 * i + 2 * j] * __uint_as_float(ww[j] << 16) + q[8 * i + 2 * j + 1] * __uint_as_float(ww[j] & 0xffff0000u); }
        if (bias_h >= 0) s += cq - cum[(size_t)kr * 4 + bias_h];
        sc[k] = s; mx = fmaxf(mx, s);
    }
    mx = wave_max(mx);
    asm volatile("s_waitcnt lgkmcnt(0)" ::: "memory");
    float sum = 0.f;
    for (int k = lane; k < nk; k += 64) { const float p = exp2f(sc[k] - mx); sc[k] = p; sum += p; }
    sum = wave_sum(sum);
    asm volatile("s_waitcnt lgkmcnt(0)" ::: "memory");
    float a0 = 0.f, a1 = 0.f;
    for (int k = 0; k < nk; ++k) {
        const int kr = k < NMETA ? MAIN + k : b * SEQ + (k - NMETA);
        const float p = sc[k];
        a0 += p * bf2f(z[(size_t)kr * ZW + vcol + lane]);
        if (two_v) a1 += p * bf2f(z[(size_t)kr * ZW + vcol + 64 + lane]);
    }
    asm volatile("s_waitcnt lgkmcnt(0)" ::: "memory");
    const float inv = 1.0f / sum; o0 = a0 * inv; o1 = a1 * inv;
}
__global__ __launch_bounds__(256) void k_final(float* __restrict__ dout, const float* __restrict__ g) {
    const int lane = threadIdx.x & 63;
    const int gw = (blockIdx.x * blockDim.x + threadIdx.x) >> 6, nw = (gridDim.x * blockDim.x) >> 6;
    for (int r = gw; r < MAIN; r += nw) {
        float4* p = (float4*)(dout + (size_t)r * D) + lane;
        float4 v[4]; float ss = 0.f;
#pragma unroll
        for (int j = 0; j < 4; ++j) { v[j] = p[64 * j]; ss += v[j].x * v[j].x + v[j].y * v[j].y + v[j].z * v[j].z + v[j].w * v[j].w; }
        ss = wave_sum(ss);
        const float rstd = 1.0f / sqrtf(ss * (1.0f / D) + EPS);
#pragma unroll
        for (int j = 0; j < 4; ++j) { const float4 gj = ((const float4*)g)[lane + 64 * j];
            p[64 * j] = make_float4(v[j].x * rstd * gj.x, v[j].y * rstd * gj.y, v[j].z * rstd * gj.z, v[j].w * rstd * gj.w); }
    }
}

__global__ __launch_bounds__(256) void k_attn_naive_l(const bf16_t* __restrict__ z, const float* __restrict__ cum, const float* __restrict__ lamp, const float* __restrict__ subg, bf16_t* __restrict__ mix) {
    __shared__ float scs[4][2080];
    const int lane = threadIdx.x & 63, w = threadIdx.x >> 6;
    const int gw = blockIdx.x * 4 + w, nw = gridDim.x * 4;
    const float lam = lamp[0], oml = lamp[1];
    float* sc = scs[w];
    for (int item = gw; item < MVALID * 8; item += nw) {
        const int r = item >> 3, hv = item & 7;
        int b = 0, nk;
        if (r < MAIN) { b = r / SEQ; nk = NMETA + (r % SEQ) + 1; } else nk = (r - MAIN) + 1;
        if (hv < 4) {
            const int h = hv; float p0, p1, n0, n1;
            attn_map(z, cum, r, b, nk, C_DQ + 128 * h, C_DK + 128 * h, C_DV + 128 * h, true, -1, sc, lane, p0, p1);
            attn_map(z, cum, r, b, nk, C_DQ + 128 * h + 64, C_DK + 128 * h + 64, C_DV + 128 * h, true, -1, sc, lane, n0, n1);
            const float o0 = p0 - lam * n0, o1 = p1 - lam * n1;
            const float ss = wave_sum(o0 * o0 + o1 * o1);
            const float rstd = 1.0f / sqrtf(ss * (1.0f / 128.0f) + EPS);
            mix[(size_t)r * D + 256 + 128 * h + lane] = f2bf(o0 * rstd * subg[lane] * oml);
            mix[(size_t)r * D + 256 + 128 * h + 64 + lane] = f2bf(o1 * rstd * subg[64 + lane] * oml);
        } else {
            const int h = hv - 4; float o0, o1;
            attn_map(z, cum, r, b, nk, C_FQ + 64 * h, C_FK + 64 * h, C_FV + 64 * h, false, h, sc, lane, o0, o1);
            mix[(size_t)r * D + 768 + 64 * h + lane] = f2bf(o0);
        }
    }
}

#include <cstdio>
namespace pg8 {
#define PG8_LAS __attribute__((address_space(3)))
typedef unsigned short bf16_t;
typedef short bf16x8 __attribute__((ext_vector_type(8)));
typedef float f32x4 __attribute__((ext_vector_type(4)));
typedef unsigned u32x4 __attribute__((ext_vector_type(4)));
constexpr int BM = 256, BK = 64, HALF = 128, HTB = HALF * BK * 2  , STAGE_BYTES = 8 * HTB, NXCD = 8, WGM = 8;

__host__ __device__ __forceinline__ int lds_byte(int r, int c) { const int st = (r >> 4) * 2 + (c >> 5), rr = r & 15, cc = c & 31, ob = rr * 64 + cc * 2; return st * 1024 + (ob ^ (((ob >> 9) & 1) << 5)); }
__host__ __device__ __forceinline__ void stage_rc(int b, int& R, int& C) { const int st = b / 1024, sb = b % 1024, swz = sb ^ (((sb >> 9) & 1) << 5); R = (st >> 1) * 16 + swz / 64; C = (st & 1) * 32 + (swz % 64) / 2; }
__host__ __device__ __forceinline__ int perm32(int rho) { const int n = rho >> 4, i = rho & 15; return 8 * (i >> 2) + 4 * n + (i & 3); }

struct Unit { int pm, pn; };
struct Gemm { const bf16_t* A; const bf16_t* Bt; int M, N, K; };

struct StaticOrder {
    int nM, nN, nwg, G, c;
    __host__ __device__ void init(int M, int N, int G_, int c_) { nM = M / BM; nN = N / BM; nwg = nM * nN; G = G_; c = c_; }
    __host__ __device__ bool next(int i, Unit& u) const {
        const long L = (long)i * G + c; if (L >= nwg) return false;
        int wgid = (int)L; { const int q = nwg / NXCD, r = nwg % NXCD, xcd = wgid % NXCD, off = wgid / NXCD; wgid = (xcd < r ? xcd * (q + 1) : r * (q + 1) + (xcd - r) * q) + off; }
        const int nig = WGM * nN, gid = wgid / nig, fm = gid * WGM, gsz = (nM - fm) < WGM ? (nM - fm) : WGM;
        u.pm = fm + ((wgid % nig) % gsz); u.pn = (wgid % nig) / gsz; return true;
    }
    __device__ __forceinline__ void a_ready(const Unit&) const {}
    __device__ __forceinline__ void done(const Unit&) const {}
    static constexpr bool GATHER = false;
    __device__ __forceinline__ const char* a_ptr(const Gemm& g, const Unit& u) const { return (const char*)g.A + (size_t)u.pm * ((size_t)BM * g.K * 2); }
    __device__ __forceinline__ const char* b_ptr(const Gemm& g, const Unit& u) const { return (const char*)g.Bt + (size_t)u.pn * ((size_t)BM * g.K * 2); }
    __device__ __forceinline__ void gather_offs(const Gemm&, const Unit&, const int (&)[2], const int (&)[2], unsigned (&)[2][2]) const {}
};

__device__ __forceinline__ unsigned cvt_pk_bf16(float lo, float hi) { unsigned r; asm volatile("v_cvt_pk_bf16_f32 %0, %1, %2" : "=v"(r) : "v"(lo), "v"(hi)); return r; }
typedef float f32x2 __attribute__((ext_vector_type(2)));
__device__ __forceinline__ f32x2 gelu_pk(f32x2 v) {
    const f32x2 av = __builtin_elementwise_abs(v), d = av * 0.2316418882f + 1.0f;
    f32x2 t; t.x = __builtin_amdgcn_rcpf(d.x); t.y = __builtin_amdgcn_rcpf(d.y);
    f32x2 q = t * 0.5307027145f + (-0.7265760135f); q = q * t + 0.7107068705f; q = q * t + (-0.142248368f); q = q * t + 0.127414796f; q = q * t;
    const f32x2 s = (v * v) * (-0.72134752044f);
    f32x2 e; e.x = __builtin_amdgcn_exp2f(s.x); e.y = __builtin_amdgcn_exp2f(s.y);
    const f32x2 m = v * (q * e), r = v - m;
    f32x2 o; o.x = v.x < 0.f ? m.x : r.x; o.y = v.y < 0.f ? m.y : r.y; return o;
}

template <int ACT  > struct EpiBf16 {
    static constexpr bool PERM = true, AFTER_DRAIN = false; static_assert(ACT == 0 || ACT == 1, "EpiBf16: ACT is 0 (none) or 1 (gelu_pk)");
    bf16_t* O; int ldc; const float* bias; int split_cols; size_t split_stride; float scale0;
    __device__ __forceinline__ void operator()(const f32x4 (&acc)[2][2][4][2], const Unit& u, int wr, int wc, int fr, int fq) const {
        const int row0 = u.pm * BM + wr * 64 + fr; int colt = u.pn * BM; bf16_t* base = O;
        float sc = 1.f; if (split_cols) { const int t = colt / split_cols; base += (size_t)t * split_stride; colt -= t * split_cols; if (t == 0) sc = scale0; }
        const int col0 = colt + wc * 32 + 8 * fq, bcol0 = u.pn * BM + wc * 32 + 8 * fq;
        f32x4 bv[2][2];
#pragma unroll
        for (int bj = 0; bj < 2; ++bj)
#pragma unroll
            for (int n = 0; n < 2; ++n) bv[bj][n] = bias ? *(const f32x4*)(bias + bcol0 + bj * HALF + 4 * n) : (f32x4){0.f, 0.f, 0.f, 0.f};
#pragma unroll
        for (int ai = 0; ai < 2; ++ai)
#pragma unroll
            for (int m = 0; m < 4; ++m) { bf16_t* rowp = base + (size_t)(row0 + ai * HALF + m * 16) * ldc + col0;
#pragma unroll
                for (int bj = 0; bj < 2; ++bj) { f32x4 v0 = acc[ai][bj][m][0] + bv[bj][0], v1 = acc[ai][bj][m][1] + bv[bj][1];
                    if (ACT == 1) { f32x2 a = gelu_pk((f32x2){v0[0], v0[1]}), b = gelu_pk((f32x2){v0[2], v0[3]}), c = gelu_pk((f32x2){v1[0], v1[1]}), d = gelu_pk((f32x2){v1[2], v1[3]});
                        v0 = (f32x4){a.x, a.y, b.x, b.y}; v1 = (f32x4){c.x, c.y, d.x, d.y}; }
                    v0 = v0 * sc; v1 = v1 * sc; u32x4 w; w.x = cvt_pk_bf16(v0[0], v0[1]); w.y = cvt_pk_bf16(v0[2], v0[3]); w.z = cvt_pk_bf16(v1[0], v1[1]); w.w = cvt_pk_bf16(v1[2], v1[3]);
                    *(u32x4*)(rowp + bj * HALF) = w; } }
    }
};

struct PanelStats {
    unsigned* xbuf;
    unsigned* cnt;
    unsigned* tmo;
    int ntn; float eps;
    unsigned code;
    __device__ __forceinline__ bool run(const f32x4 (&v)[2][2][4][2], const Unit& u, int wr, int wc, int fr, int fq, PG8_LAS unsigned char* lds, int wid, int lane) const {
        typedef float f32x2v __attribute__((ext_vector_type(2)));
        PG8_LAS f32x2v* P = (PG8_LAS f32x2v*)lds;
        PG8_LAS f32x2v* S = (PG8_LAS f32x2v*)(lds + 8192);
        PG8_LAS unsigned* flag = (PG8_LAS unsigned*)(lds + 8192 + 2048);
#pragma unroll
        for (int ai = 0; ai < 2; ++ai)
#pragma unroll
            for (int m = 0; m < 4; ++m) {
                float s = 0.f;
#pragma unroll
                for (int bj = 0; bj < 2; ++bj)
#pragma unroll
                    for (int n = 0; n < 2; ++n) { const f32x4 x = v[ai][bj][m][n]; s += (x[0] + x[1]) + (x[2] + x[3]); }
                s += __shfl_xor(s, 16); s += __shfl_xor(s, 32);
                const float mw = s * (1.0f / 64.0f); float q = 0.f;
#pragma unroll
                for (int bj = 0; bj < 2; ++bj)
#pragma unroll
                    for (int n = 0; n < 2; ++n) { const f32x4 d = v[ai][bj][m][n] - mw; q += (d[0] * d[0] + d[1] * d[1]) + (d[2] * d[2] + d[3] * d[3]); }
                q += __shfl_xor(q, 16); q += __shfl_xor(q, 32);
                if (fq == 0) P[(ai * HALF + wr * 64 + m * 16 + fr) * 4 + wc] = (f32x2v){mw, q};
            }
        asm volatile("s_waitcnt lgkmcnt(0)" ::: "memory"); __builtin_amdgcn_s_barrier(); asm volatile("" ::: "memory");
#if defined(BROKEN_EXCHANGE_NO_WAIT)
#warning BROKEN CONTROL BUILD: the row-statistics exchange does not wait; results are wrong by design
        if (blockIdx.x >= 64) { const long long t0_ = clock64(); while (clock64() - t0_ < 60000) __builtin_amdgcn_s_sleep(8); }
#endif
        const int row = wid * 32 + (lane & 31);
        if (lane < 32) {
            const f32x2v a = P[row * 4 + 0], b = P[row * 4 + 1], c = P[row * 4 + 2], d = P[row * 4 + 3];
            const float mt = (a.x + b.x + c.x + d.x) * 0.25f;
            const float da = a.x - mt, db = b.x - mt, dc = c.x - mt, dd = d.x - mt;
            const float m2 = (a.y + b.y) + (c.y + d.y) + 64.0f * ((da * da + db * db) + (dc * dc + dd * dd));
            unsigned long long* slot = (unsigned long long*)xbuf + ((size_t)(u.pm * BM + row) * 4 + u.pn);
            __hip_atomic_store(slot, ((unsigned long long)__float_as_uint(m2) << 32) | __float_as_uint(mt), __ATOMIC_RELAXED, __HIP_MEMORY_SCOPE_AGENT);
        }
        asm volatile("s_waitcnt vmcnt(0)" ::: "memory");
        if (lane == 0) __hip_atomic_fetch_add(cnt + 64 * u.pm, 1u, __ATOMIC_RELAXED, __HIP_MEMORY_SCOPE_AGENT);
        if (wid == 0) {
            bool dead = false; const unsigned long long t0 = __builtin_amdgcn_s_memrealtime(); const unsigned want = 8u * (unsigned)ntn;
            for (;;) {
#if defined(BROKEN_EXCHANGE_NO_WAIT)
                break;
#endif
                if ((unsigned)__builtin_amdgcn_readfirstlane(__hip_atomic_load(cnt + 64 * u.pm, __ATOMIC_RELAXED, __HIP_MEMORY_SCOPE_AGENT)) >= want) break;
                if (__builtin_amdgcn_s_memrealtime() - t0 > 2000000ull) {
                    if (lane == 0) { unsigned expect = 0u; __hip_atomic_compare_exchange_strong(tmo + 1, &expect, code | (unsigned)(u.pm & 0xff), __ATOMIC_RELAXED, __ATOMIC_RELAXED, __HIP_MEMORY_SCOPE_AGENT);
                                     __hip_atomic_store(tmo, 1u, __ATOMIC_RELAXED, __HIP_MEMORY_SCOPE_AGENT); }
                    dead = true; break; }
                __builtin_amdgcn_s_sleep(2);
            }
            __builtin_amdgcn_fence(__ATOMIC_ACQUIRE, "agent");
            if (lane == 0) flag[0] = dead ? 1u : 0u;
        }
        asm volatile("s_waitcnt vmcnt(0) lgkmcnt(0)" ::: "memory"); __builtin_amdgcn_s_barrier(); asm volatile("" ::: "memory");
        const bool bad = flag[0] != 0u;
        if (lane < 32) {
            const unsigned long long* slot = (const unsigned long long*)xbuf + (size_t)(u.pm * BM + row) * 4; float mt[4], m2[4]; float ms = 0.f;
#pragma unroll
            for (int t = 0; t < 4; ++t) { if (t < ntn) { const unsigned long long w = __hip_atomic_load(slot + t, __ATOMIC_RELAXED, __HIP_MEMORY_SCOPE_AGENT); mt[t] = __uint_as_float((unsigned)w); m2[t] = __uint_as_float((unsigned)(w >> 32)); } else { mt[t] = 0.f; m2[t] = 0.f; } ms += mt[t]; }
            const float mean = ms / (float)ntn; float q = 0.f;
#pragma unroll
            for (int t = 0; t < 4; ++t) if (t < ntn) { const float dm = mt[t] - mean; q += m2[t] + 256.0f * dm * dm; }
            S[row] = (f32x2v){mean, 1.0f / sqrtf(q / (256.0f * (float)ntn) + eps)};
        }
        asm volatile("s_waitcnt lgkmcnt(0)" ::: "memory"); __builtin_amdgcn_s_barrier(); asm volatile("" ::: "memory");
        return bad;
    }
};
struct EpiLnRes {
    static constexpr bool PERM = false, AFTER_DRAIN = true;
    const float* base; float* out; int ldc; const float* bias; PanelStats st; unsigned poison;
    __device__ __forceinline__ void fused(f32x4 (&acc)[2][2][4][2], const Unit& u, int wr, int wc, int fr, int fq, PG8_LAS unsigned char* lds, int wid, int lane) const {
        typedef float f32x2v __attribute__((ext_vector_type(2)));
        const PG8_LAS f32x2v* S = (const PG8_LAS f32x2v*)(lds + 8192);
        const int col0 = u.pn * BM + wc * 32 + 4 * fq;
#pragma unroll
        for (int bj = 0; bj < 2; ++bj)
#pragma unroll
            for (int n = 0; n < 2; ++n) { const f32x4 bv = bias ? *(const f32x4*)(bias + col0 + bj * HALF + n * 16) : (f32x4){0.f, 0.f, 0.f, 0.f};
#pragma unroll
                for (int ai = 0; ai < 2; ++ai)
#pragma unroll
                    for (int m = 0; m < 4; ++m) acc[ai][bj][m][n] += bv; }
        f32x4 pre[4][2][2];
#pragma unroll
        for (int m = 0; m < 4; ++m) { const size_t off = (size_t)(u.pm * BM + wr * 64 + m * 16 + fr) * ldc + col0;
#pragma unroll
            for (int bj = 0; bj < 2; ++bj)
#pragma unroll
                for (int n = 0; n < 2; ++n) pre[m][bj][n] = *(const f32x4*)(base + off + bj * HALF + n * 16); }
        const bool bad = st.run(acc, u, wr, wc, fr, fq, lds, wid, lane) || poison != 0u;
        const float qnan = __builtin_nanf("");
#pragma unroll
        for (int ai = 0; ai < 2; ++ai)
#pragma unroll
            for (int m = 0; m < 4; ++m) { const int r = ai * HALF + wr * 64 + m * 16 + fr; const f32x2v sr = S[r]; const size_t off = (size_t)(u.pm * BM + r) * ldc + col0;
#pragma unroll
                for (int bj = 0; bj < 2; ++bj)
#pragma unroll
                    for (int n = 0; n < 2; ++n) { const f32x4 bs = ai == 0 ? pre[m][bj][n] : *(const f32x4*)(base + off + bj * HALF + n * 16); f32x4 o = bs + (acc[ai][bj][m][n] - sr.x) * sr.y;
                        if (bad) o = (f32x4){qnan, qnan, qnan, qnan}; *(f32x4*)(out + off + bj * HALF + n * 16) = o; }
                if (m & 1) asm volatile("" ::: "memory"); }
    }
};
struct EpiLnResLn {
    static constexpr bool PERM = false, AFTER_DRAIN = true;
    const float* base; float* out; bf16_t* xn; int ldc; const float* bias; PanelStats st1, st2; unsigned poison;
    __device__ __forceinline__ void fused(f32x4 (&acc)[2][2][4][2], const Unit& u, int wr, int wc, int fr, int fq, PG8_LAS unsigned char* lds, int wid, int lane) const {
        typedef float f32x2v __attribute__((ext_vector_type(2))); typedef unsigned u32x2v __attribute__((ext_vector_type(2)));
        const PG8_LAS f32x2v* S = (const PG8_LAS f32x2v*)(lds + 8192);
        const int col0 = u.pn * BM + wc * 32 + 4 * fq;
#pragma unroll
        for (int bj = 0; bj < 2; ++bj)
#pragma unroll
            for (int n = 0; n < 2; ++n) { const f32x4 bv = bias ? *(const f32x4*)(bias + col0 + bj * HALF + n * 16) : (f32x4){0.f, 0.f, 0.f, 0.f};
#pragma unroll
                for (int ai = 0; ai < 2; ++ai)
#pragma unroll
                    for (int m = 0; m < 4; ++m) acc[ai][bj][m][n] += bv; }
        bool bad = st1.run(acc, u, wr, wc, fr, fq, lds, wid, lane) || poison != 0u;
        const float qnan = __builtin_nanf("");
#pragma unroll
        for (int ai = 0; ai < 2; ++ai)
#pragma unroll
            for (int m = 0; m < 4; ++m) { const int r = ai * HALF + wr * 64 + m * 16 + fr; const f32x2v sr = S[r]; const size_t off = (size_t)(u.pm * BM + r) * ldc + col0;
#pragma unroll
                for (int bj = 0; bj < 2; ++bj)
#pragma unroll
                    for (int n = 0; n < 2; ++n) { const f32x4 bs = *(const f32x4*)(base + off + bj * HALF + n * 16); acc[ai][bj][m][n] = bs + (acc[ai][bj][m][n] - sr.x) * sr.y; }
                asm volatile("" : "+v"(acc[ai][0][m][0]), "+v"(acc[ai][0][m][1]), "+v"(acc[ai][1][m][0]), "+v"(acc[ai][1][m][1]));
                if (m & 1) asm volatile("" ::: "memory"); }
        const bool bad1 = bad;
        bad = st2.run(acc, u, wr, wc, fr, fq, lds, wid, lane) || bad;
#pragma unroll
        for (int ai = 0; ai < 2; ++ai)
#pragma unroll
            for (int m = 0; m < 4; ++m) { const int r = ai * HALF + wr * 64 + m * 16 + fr; const f32x2v sr = S[r]; const size_t off = (size_t)(u.pm * BM + r) * ldc + col0;
#pragma unroll
                for (int bj = 0; bj < 2; ++bj)
#pragma unroll
                    for (int n = 0; n < 2; ++n) { const f32x4 x1 = acc[ai][bj][m][n]; *(f32x4*)(out + off + bj * HALF + n * 16) = bad1 ? (f32x4){qnan, qnan, qnan, qnan} : x1;
                        const f32x4 o = (x1 - sr.x) * sr.y; u32x2v w; w.x = cvt_pk_bf16(o[0], o[1]); w.y = cvt_pk_bf16(o[2], o[3]);
                        if (bad) { w.x = 0x7fc07fc0u; w.y = 0x7fc07fc0u; } *(u32x2v*)(xn + off + bj * HALF + n * 16) = w; }
                asm volatile("" ::: "memory"); }
    }
};

typedef int i32x8_t __attribute__((ext_vector_type(8)));
typedef int i32x4_t __attribute__((ext_vector_type(4)));
template <bool F8> struct FragT; template <> struct FragT<false> { typedef bf16x8 T[2]; }; template <> struct FragT<true> { typedef i32x8_t T; };
__device__ __forceinline__ void mfma_f8(f32x4& acc, const i32x8_t& a, const i32x8_t& b, int sc) {
    asm volatile("v_mfma_scale_f32_16x16x128_f8f6f4 %0, %1, %2, %0, %3, %3 op_sel_hi:[0,0,0]" : "+v"(acc) : "v"(a), "v"(b), "v"(sc)); }
__device__ __forceinline__ i32x8_t ld32(const PG8_LAS unsigned char* p) { const i32x4_t x = *(const PG8_LAS i32x4_t*)p, y = *(const PG8_LAS i32x4_t*)(p + 1024); return __builtin_shufflevector(x, y, 0, 1, 2, 3, 4, 5, 6, 7); }
template <class Epi, class Sched, bool ALIGN_EPI = false, bool SP2 = false, bool FP8 = false>
__device__ __forceinline__ void gemm_phase(PG8_LAS unsigned char* lds, const Gemm g, const Sched& S, const Epi& E) {
    int tid_ = threadIdx.x; asm volatile("" : "+v"(tid_));
    const int tid = tid_, wid = __builtin_amdgcn_readfirstlane(tid >> 6), lane = tid & 63, wr = wid >> 2, wc = wid & 3, fr = lane & 15, fq = lane >> 4;
    const int K = g.K, nt = K / BK;
    unsigned voffA[2], voffB[2]; int stR[2], stC[2]; unsigned voC[2][2] = {{0u, 0u}, {0u, 0u}}, voN[2][2] = {{0u, 0u}, {0u, 0u}};
#pragma unroll
    for (int i = 0; i < 2; ++i) { int R, C; stage_rc(tid * 16 + i * 8192, R, C); const int Rb = Epi::PERM ? ((R & ~31) + perm32(R & 31)) : R;
        voffA[i] = (unsigned)(R * K + C) * 2u; voffB[i] = (unsigned)(Rb * K + C) * 2u; stR[i] = R; stC[i] = C; }
    const size_t kstep = (size_t)(BK * 2);
    const size_t hstep = (size_t)HALF * K * 2;
    const size_t tstep = 2 * hstep;
    const unsigned ldsw = (unsigned)wid * 1024u;
    const int aoff = lds_byte(wr * 64 + fr, fq * 8), boff = lds_byte(wc * 32 + fr, fq * 8);
#define PG8_SA(b, h) (((b) * 2 + (h)) * HTB)
#define PG8_SB(b, h) ((4 + (b) * 2 + (h)) * HTB)
#define PG8_STAGE(bufoff, gbase, voff) do { _Pragma("unroll") for (int _i = 0; _i < 2; ++_i) \
        __builtin_amdgcn_global_load_lds((const unsigned*)((const char*)(gbase) + (voff)[_i]), (PG8_LAS unsigned*)(lds + (bufoff) + ldsw + _i * 8192), 16, 0, 0); } while (0)
#define PG8_STAGE_A(bufoff, gbase, h, nx) do { if constexpr (Sched::GATHER) { _Pragma("unroll") for (int _i = 0; _i < 2; ++_i) { const unsigned _o = (nx) ? voN[h][_i] : voC[h][_i]; \
        __builtin_amdgcn_global_load_lds((const unsigned*)((const char*)(gbase) + _o), (PG8_LAS unsigned*)(lds + (bufoff) + ldsw + _i * 8192), 16, 0, 0); } } \
        else { PG8_STAGE(bufoff, (gbase) + (size_t)(h) * hstep, voffA); } } while (0)
#define PG8_LDA(dst, b, h) do { _Pragma("unroll") for (int m = 0; m < 4; ++m) { if constexpr (FP8) { dst[m] = ld32(lds + PG8_SA(b, h) + aoff + m * 2048); } else { _Pragma("unroll") for (int k = 0; k < 2; ++k) dst[m][k] = *(const PG8_LAS bf16x8*)(lds + PG8_SA(b, h) + aoff + m * 2048 + k * 1024); } } } while (0)
#define PG8_LDB(dst, b, h) do { _Pragma("unroll") for (int n = 0; n < 2; ++n) { if constexpr (FP8) { dst[n] = ld32(lds + PG8_SB(b, h) + boff + n * 2048); } else { _Pragma("unroll") for (int k = 0; k < 2; ++k) dst[n][k] = *(const PG8_LAS bf16x8*)(lds + PG8_SB(b, h) + boff + n * 2048 + k * 1024); } } } while (0)
#define PG8_MMA(ai, bj, At, Bt) do { __builtin_amdgcn_s_setprio(1); _Pragma("unroll") for (int m = 0; m < 4; ++m) _Pragma("unroll") for (int n = 0; n < 2; ++n) { \
        if constexpr (FP8) mfma_f8(acc[ai][bj][m][n], Bt[n], At[m], f8scale); \
        else { _Pragma("unroll") for (int k = 0; k < 2; ++k) acc[ai][bj][m][n] = __builtin_amdgcn_mfma_f32_16x16x32_bf16(Bt[n][k], At[m][k], acc[ai][bj][m][n], 0, 0, 0); } } \
        __builtin_amdgcn_s_setprio(0); } while (0)
#define PG8_WAIT_V(n) asm volatile("s_waitcnt vmcnt(" #n ")" ::: "memory")
#define PG8_WAIT_L(n) asm volatile("s_waitcnt lgkmcnt(" #n ")" ::: "memory")
#define PG8_BAR __builtin_amdgcn_s_barrier()
#define PG8_SCHED __builtin_amdgcn_sched_barrier(0)
    Unit cur, nxt; int ui = 0;
    int f8scale = 0x7F7F7F7F; asm volatile("" : "+v"(f8scale)); (void)f8scale;
    if (!S.next(0, cur)) return;
    f32x4 acc[2][2][4][2];
#pragma unroll
    for (int a = 0; a < 2; ++a)
#pragma unroll
        for (int b = 0; b < 2; ++b)
#pragma unroll
            for (int m = 0; m < 4; ++m)
#pragma unroll
                for (int n = 0; n < 2; ++n) acc[a][b][m][n] = (f32x4){0.f, 0.f, 0.f, 0.f};
    typename FragT<FP8>::T At[4], B0[2], B1[2];
    const char* cA = S.a_ptr(g, cur); const char* cB = S.b_ptr(g, cur);
    if constexpr (Sched::GATHER) S.gather_offs(g, cur, stR, stC, voC);
    S.a_ready(cur);
    if constexpr (SP2) {
        PG8_STAGE(PG8_SB(0, 0), cB, voffB); PG8_STAGE(PG8_SB(0, 1), cB + hstep, voffB); PG8_STAGE_A(PG8_SA(0, 0), cA, 0, false); PG8_STAGE_A(PG8_SA(0, 1), cA, 1, false);
        if (wr == 1) PG8_BAR;
        PG8_WAIT_V(2); PG8_BAR;
        PG8_STAGE(PG8_SB(1, 0), cB + kstep, voffB); PG8_STAGE_A(PG8_SA(1, 0), cA + kstep, 0, false); PG8_STAGE(PG8_SB(1, 1), cB + hstep + kstep, voffB);
        PG8_WAIT_V(6); PG8_BAR;
    } else {
        PG8_STAGE(PG8_SB(0, 0), cB, voffB); PG8_STAGE_A(PG8_SA(0, 0), cA, 0, false); PG8_STAGE(PG8_SB(0, 1), cB + hstep, voffB); PG8_STAGE_A(PG8_SA(0, 1), cA, 1, false);
        if (wr == 1) PG8_BAR;
        PG8_WAIT_V(4); PG8_BAR;
        PG8_STAGE(PG8_SB(1, 0), cB + kstep, voffB); PG8_STAGE_A(PG8_SA(1, 0), cA + kstep, 0, false); PG8_STAGE(PG8_SB(1, 1), cB + hstep + kstep, voffB);
        PG8_WAIT_V(6); PG8_BAR;
    }
    for (;;) {
        const bool has_next = S.next(ui + 1, nxt);
        const char* nA = has_next ? S.a_ptr(g, nxt) : cA; const char* nB = has_next ? S.b_ptr(g, nxt) : cB;
        if constexpr (Sched::GATHER) { if (has_next) S.gather_offs(g, nxt, stR, stC, voN); }
        for (int t = 0; t < nt; t += 2) {
            const bool last = (t == nt - 2); const bool nx = last && has_next; (void)nx;
            const char* a1 = cA + (size_t)(t + 1) * kstep;
            const char* a2 = last ? nA : cA + (size_t)(t + 2) * kstep; const char* b2 = last ? nB : cB + (size_t)(t + 2) * kstep;
            const char* a3 = a2 + kstep; const char* b3 = b2 + kstep;
            if (last && has_next) S.a_ready(nxt);
            if constexpr (SP2) {
            PG8_LDB(B0, 0, 0); PG8_LDB(B1, 0, 1); PG8_SCHED; PG8_LDA(At, 0, 0); PG8_STAGE_A(PG8_SA(1, 1), a1, 1, false);
            PG8_WAIT_V(8); PG8_WAIT_L(0); PG8_BAR; PG8_MMA(0, 0, At, B0); PG8_MMA(0, 1, At, B1); PG8_BAR; PG8_SCHED;
            PG8_LDA(At, 0, 1); PG8_STAGE(PG8_SB(0, 0), b2, voffB); PG8_STAGE(PG8_SB(0, 1), b2 + hstep, voffB); PG8_STAGE_A(PG8_SA(0, 0), a2, 0, nx);
            PG8_WAIT_V(8); PG8_WAIT_L(0); PG8_BAR; PG8_MMA(1, 0, At, B0); PG8_MMA(1, 1, At, B1); PG8_BAR; PG8_SCHED;
            PG8_LDB(B0, 1, 0); PG8_LDB(B1, 1, 1); PG8_SCHED; PG8_LDA(At, 1, 0); PG8_STAGE_A(PG8_SA(0, 1), a2, 1, nx);
            PG8_WAIT_V(8); PG8_WAIT_L(0); PG8_BAR; PG8_MMA(0, 0, At, B0); PG8_MMA(0, 1, At, B1); PG8_BAR; PG8_SCHED;
            PG8_LDA(At, 1, 1); PG8_STAGE(PG8_SB(1, 0), b3, voffB); PG8_STAGE(PG8_SB(1, 1), b3 + hstep, voffB); PG8_STAGE_A(PG8_SA(1, 0), a3, 0, nx);
            PG8_WAIT_V(8); PG8_WAIT_L(0); PG8_BAR; PG8_MMA(1, 0, At, B0); PG8_MMA(1, 1, At, B1); PG8_BAR; PG8_SCHED;
            } else {
            PG8_LDB(B0, 0, 0); PG8_SCHED; PG8_LDA(At, 0, 0); PG8_STAGE_A(PG8_SA(1, 1), a1, 1, false);
            PG8_WAIT_L(8); PG8_BAR; PG8_WAIT_L(0); PG8_MMA(0, 0, At, B0); PG8_BAR; PG8_SCHED;
            PG8_LDB(B1, 0, 1); PG8_STAGE(PG8_SB(0, 0), b2, voffB);
            PG8_BAR; PG8_WAIT_L(0); PG8_MMA(0, 1, At, B1); PG8_BAR;
            PG8_LDA(At, 0, 1); PG8_STAGE_A(PG8_SA(0, 0), a2, 0, nx);
            PG8_BAR; PG8_WAIT_L(0); PG8_MMA(1, 0, At, B0); PG8_BAR; PG8_SCHED;
            PG8_STAGE(PG8_SB(0, 1), b2 + hstep, voffB);
            PG8_WAIT_V(6); PG8_BAR; PG8_MMA(1, 1, At, B1); PG8_BAR;
            PG8_LDB(B0, 1, 0); PG8_SCHED; PG8_LDA(At, 1, 0); PG8_STAGE_A(PG8_SA(0, 1), a2, 1, nx);
            PG8_WAIT_L(8); PG8_BAR; PG8_WAIT_L(0); PG8_MMA(0, 0, At, B0); PG8_BAR; PG8_SCHED;
            PG8_LDB(B1, 1, 1); PG8_STAGE(PG8_SB(1, 0), b3, voffB);
            PG8_BAR; PG8_WAIT_L(0); PG8_MMA(0, 1, At, B1); PG8_BAR;
            PG8_LDA(At, 1, 1); PG8_STAGE_A(PG8_SA(1, 0), a3, 0, nx);
            PG8_BAR; PG8_WAIT_L(0); PG8_MMA(1, 0, At, B0); PG8_BAR; PG8_SCHED;
            PG8_STAGE(PG8_SB(1, 1), b3 + hstep, voffB);
            PG8_WAIT_V(6); PG8_BAR; PG8_MMA(1, 1, At, B1); PG8_BAR;
            }
        }
        if constexpr (FP8) asm volatile("s_nop 15\n\ts_nop 15" ::: "memory");
        if constexpr (ALIGN_EPI) { if (wr == 0) PG8_BAR; }
        if constexpr (!Epi::AFTER_DRAIN) { E(acc, cur, wr, wc, fr, fq); S.done(cur); }
        if (!has_next) break;
#pragma unroll
        for (int a = 0; a < 2; ++a)
#pragma unroll
            for (int b = 0; b < 2; ++b)
#pragma unroll
                for (int m = 0; m < 4; ++m)
#pragma unroll
                    for (int n = 0; n < 2; ++n) acc[a][b][m][n] = (f32x4){0.f, 0.f, 0.f, 0.f};
        cur = nxt; cA = nA; cB = nB; ++ui;
        if constexpr (Sched::GATHER) { voC[0][0] = voN[0][0]; voC[0][1] = voN[0][1]; voC[1][0] = voN[1][0]; voC[1][1] = voN[1][1]; }
        if constexpr (ALIGN_EPI) { if (wr == 1) PG8_BAR; }
    }
    PG8_WAIT_V(0);
    if constexpr (!ALIGN_EPI) { if (wr == 0) PG8_BAR; }
    PG8_BAR;
    if constexpr (Epi::AFTER_DRAIN) { E.fused(acc, cur, wr, wc, fr, fq, lds, wid, lane); S.done(cur); }
#undef PG8_SA
#undef PG8_SB
#undef PG8_STAGE
#undef PG8_STAGE_A
#undef PG8_LDA
#undef PG8_LDB
#undef PG8_MMA
#undef PG8_WAIT_V
#undef PG8_WAIT_L
#undef PG8_BAR
#undef PG8_SCHED
}
}

#define GAS __attribute__((address_space(1)))
#define LAS __attribute__((address_space(3)))
typedef unsigned v4u __attribute__((ext_vector_type(4)));
typedef float f32x4 __attribute__((ext_vector_type(4)));
typedef short bf16x8 __attribute__((ext_vector_type(8)));
typedef GAS unsigned gu32;
typedef GAS unsigned long long gu64;
#define RLX_AGENT __ATOMIC_RELAXED, __HIP_MEMORY_SCOPE_AGENT
#define LDS_WAIT() asm volatile("s_waitcnt lgkmcnt(0)" ::: "memory")
#define VM_WAIT() asm volatile("s_waitcnt vmcnt(0)" ::: "memory")
__device__ __forceinline__ unsigned long long rt() { return __builtin_amdgcn_s_memrealtime(); }
__device__ __forceinline__ unsigned f2bf_u(float f) { unsigned u = __builtin_bit_cast(unsigned, f); return (u + 0x7fffu + ((u >> 16) & 1u)) >> 16; }
__device__ __forceinline__ unsigned pk2(float lo, float hi) { return f2bf_u(lo) | (f2bf_u(hi) << 16); }

#define XB_TMO      128
#define XB_XCNT(j)  (256  + 64 * (j))
#define XB_XSUB(j)  (1280 + 64 * (j))
#define XB_XGEN(j)  (2304 + 64 * (j))
#define XB_TOP      3328
#define XB_TOPGEN   3392
#define XCD_BAR_WORDS 3456
#define XB_SPIN_CAP (1u << 18)

__device__ __forceinline__ unsigned xb_ld(unsigned* p)              { return __hip_atomic_load(p, __ATOMIC_RELAXED, __HIP_MEMORY_SCOPE_AGENT); }
__device__ __forceinline__ unsigned xb_add(unsigned* p, unsigned v) { return __hip_atomic_fetch_add(p, v, __ATOMIC_RELAXED, __HIP_MEMORY_SCOPE_AGENT); }
__device__ __forceinline__ unsigned xb_xcc_id() { return (unsigned)__builtin_amdgcn_s_getreg((3 << 11) | 20) & 0xFu; }
#define XB_SPIN(cond, bar) do { unsigned _sp = 0; while (cond) { __builtin_amdgcn_s_sleep(1); \
    if ((++_sp & 255u) == 0u) { if (xb_ld(&(bar)[XB_TMO])) break; if (_sp > XB_SPIN_CAP) { atomicAdd(&(bar)[XB_TMO], 1u); break; } } } } while (0)

struct XcdBarrier {
    unsigned* bar; unsigned x;
    volatile LAS unsigned* st;
};

__device__ __forceinline__ XcdBarrier xcd_barrier_post(unsigned* bar, volatile LAS unsigned* st) {
    XcdBarrier b; b.bar = bar; b.x = xb_xcc_id(); b.st = st;
    if (threadIdx.x == 0) (void)xb_add(&bar[XB_XCNT(b.x)], 1u);
    return b;
}
__device__ __forceinline__ void xcd_barrier_complete(unsigned* bar, unsigned x, unsigned& nloc, unsigned& nx) {
    const unsigned G = gridDim.x * gridDim.y * gridDim.z;
    unsigned sum, cnt, mine, sp = 0u;
    for (;;) {
        sum = 0u; cnt = 0u; mine = 0u;
#pragma unroll
        for (unsigned j = 0; j < 16; ++j) { const unsigned c = xb_ld(&bar[XB_XCNT(j)]); sum += c; cnt += (c > 0u) ? 1u : 0u; mine = (j == x) ? c : mine; }
        if (sum == G) break;
        __builtin_amdgcn_s_sleep(1);
        if ((++sp & 255u) == 0u) { if (xb_ld(&bar[XB_TMO])) break; if (sp > XB_SPIN_CAP) { atomicAdd(&bar[XB_TMO], 1u); break; } }
    }
    nloc = mine > 0u ? mine : 1u; nx = cnt > 0u ? cnt : 1u;
}

__device__ __forceinline__ void xcd_barrier(const XcdBarrier& b) {
    asm volatile("s_waitcnt vmcnt(0)" ::: "memory");
    __syncthreads();
    if (threadIdx.x == 0) {
        unsigned* bar = b.bar;
        __builtin_amdgcn_s_waitcnt(0);
        unsigned nloc = b.st[0], nx = b.st[1];
        if (nloc == 0u) { xcd_barrier_complete(bar, b.x, nloc, nx); b.st[0] = nloc; b.st[1] = nx; }
        const unsigned old = xb_add(&bar[XB_XSUB(b.x)], 1u);
        const unsigned gen = old / nloc;
        if (old + 1u == (gen + 1u) * nloc) {
            __builtin_amdgcn_fence(__ATOMIC_RELEASE, "agent");
            asm volatile("s_waitcnt vmcnt(0)" ::: "memory");
            const unsigned og = xb_add(&bar[XB_TOP], 1u);
            const unsigned tg = og / nx;
            if (og + 1u == (tg + 1u) * nx) xb_add(&bar[XB_TOPGEN], 1u);
            else XB_SPIN(xb_ld(&bar[XB_TOPGEN]) == tg, bar);
            __builtin_amdgcn_fence(__ATOMIC_ACQUIRE, "agent");
            xb_add(&bar[XB_XGEN(b.x)], 1u);
            asm volatile("s_waitcnt vmcnt(0)" ::: "memory");
        } else {
            XB_SPIN(xb_ld(&bar[XB_XGEN(b.x)]) == gen, bar);
            __builtin_amdgcn_fence(__ATOMIC_ACQUIRE, "agent");
            asm volatile("s_waitcnt vmcnt(0)" ::: "memory");
        }
    }
    __syncthreads();
}

constexpr int NWAVES = 8;
constexpr int LDS_BYTES = 147456;
constexpr int LDSCTL_OFF = 143360;
constexpr int MISC_OFF = LDSCTL_OFF + 320;

constexpr size_t W_CTL = 0, CTL_ZERO_BYTES = 1 * MiB;
constexpr size_t W_TAB = 1 * MiB;
constexpr size_t W_WE13 = 4 * MiB, W_WE2 = 116 * MiB, W_H = 172 * MiB, W_RESM = 205 * MiB, W_FG = 206 * MiB, W_CUM = 207 * MiB, W_TOK = 208 * MiB, W_LIST = 209 * MiB;
constexpr size_t W_WIN = 210 * MiB, W_WOUT = 220 * MiB, W_WGLU = 224 * MiB, W_W13 = 225 * MiB, W_W2 = 236 * MiB, W_Z = 242 * MiB, W_MIX = 324 * MiB, W_HD = 357 * MiB;
constexpr size_t W_HM = 210 * MiB;
constexpr size_t W_YM = 4 * MiB;
constexpr size_t W_END = 448 * MiB;
constexpr size_t T_LAM = 0, T_A = 4096, T_A64 = 20480, T_SMETA = 36864, T_BCT = 65536, T_CCT = 196608, T_S = 1 * MiB;
constexpr int CW_TMO = 0, CW_CODE = 1, CW_BAR = 4096, CW_QCTR = 8192, CW_ECNT = 12288;

__device__ __forceinline__ unsigned cvtpk(float lo, float hi) { unsigned r; asm volatile("v_cvt_pk_bf16_f32 %0, %1, %2" : "=v"(r) : "v"(lo), "v"(hi)); return r; }
typedef short s16x4 __attribute__((ext_vector_type(4)));
typedef float f32x16 __attribute__((ext_vector_type(16)));
typedef unsigned u32x4 __attribute__((ext_vector_type(4)));
typedef unsigned u32x2 __attribute__((ext_vector_type(2)));
#define SBAR() __builtin_amdgcn_sched_barrier(0)

__device__ __forceinline__ void tr_item(const float* __restrict__ W, int ldw, int K, bf16_t* WT, int k0, int n0, int drow0, float sc, LAS float* scr, int lane) {
#pragma unroll 8
    for (int i = 0; i < 32; ++i) { const int kk = 2 * i + (lane >> 5); scr[kk * 33 + (lane & 31)] = W[(size_t)(k0 + kk) * ldw + n0 + (lane & 31)]; }
    LDS_WAIT(); asm volatile("" ::: "memory");
    const int c = lane & 7;
#pragma unroll
    for (int j = 0; j < 4; ++j) { const int n = (lane >> 3) + 8 * j; const LAS float* s = scr + (8 * c) * 33 + n;
        v4u o; o.x = cvtpk(s[0 * 33] * sc, s[1 * 33] * sc); o.y = cvtpk(s[2 * 33] * sc, s[3 * 33] * sc); o.z = cvtpk(s[4 * 33] * sc, s[5 * 33] * sc); o.w = cvtpk(s[6 * 33] * sc, s[7 * 33] * sc);
        *(GAS v4u*)(WT + (size_t)(drow0 + n) * K + k0 + 8 * c) = o; }
    LDS_WAIT(); asm volatile("" ::: "memory");
}
__device__ __forceinline__ unsigned pk4_fp8(float a, float b, float c, float d) { int w = 0; w = __builtin_amdgcn_cvt_pk_fp8_f32(a, b, w, false); w = __builtin_amdgcn_cvt_pk_fp8_f32(c, d, w, true); return (unsigned)w; }
constexpr float WQ_SCALE = 64.0f, HQ_SCALE = 8.0f;
__device__ __forceinline__ void tr_item_fp8(const float* __restrict__ W, int ldw, int K, unsigned char* WT, int k0, int n0, int drow0, float sc, LAS float* scr, int lane) {
#pragma unroll 8
    for (int i = 0; i < 32; ++i) { const int kk = 2 * i + (lane >> 5); scr[kk * 33 + (lane & 31)] = W[(size_t)(k0 + kk) * ldw + n0 + (lane & 31)]; }
    LDS_WAIT(); asm volatile("" ::: "memory");
    const int c = lane & 7;
#pragma unroll
    for (int j = 0; j < 4; ++j) { const int n = (lane >> 3) + 8 * j; const LAS float* s = scr + (8 * c) * 33 + n;
        u32x2 o; o.x = pk4_fp8(s[0 * 33] * sc, s[1 * 33] * sc, s[2 * 33] * sc, s[3 * 33] * sc); o.y = pk4_fp8(s[4 * 33] * sc, s[5 * 33] * sc, s[6 * 33] * sc, s[7 * 33] * sc);
        *(GAS u32x2*)(WT + (size_t)(drow0 + n) * K + k0 + 8 * c) = o; }
    LDS_WAIT(); asm volatile("" ::: "memory");
}
struct MkArgs { const void* p[31]; int ph_lo, ph_hi, flags, pad; };
__device__ __forceinline__ const float* argf(const MkArgs& a, int k) { asm volatile("" : "+s"(k)); return (const float*)a.p[k]; }
__device__ __forceinline__ unsigned char* argws(const MkArgs& a) { int k = 30; asm volatile("" : "+s"(k)); return (unsigned char*)a.p[k]; }
__device__ __forceinline__ int argi(const MkArgs& a, int k) { asm volatile("" : "+s"(k)); return (&a.ph_lo)[k]; }
__device__ __forceinline__ float* argout(const MkArgs& a) { int k = 29; asm volatile("" : "+s"(k)); return (float*)a.p[k]; }

__device__ __forceinline__ void p0_prologue(const MkArgs& a, LAS unsigned char* lds, int gw, int NGW, int wave, int lane) {
    LAS float* scr = (LAS float*)(lds + wave * 16384);
    unsigned char* ws = argws(a);
    constexpr int I_IN = 2 * 16 * 80, I_OUT = 2 * 16 * 32, I_GLU = 2 * 4 * 16, I_W1 = 16 * 88, I_W3 = 16 * 88, I_W2 = 44 * 32;
    constexpr int I_E1 = 8 * 16 * 112, I_E3 = I_E1, I_E2 = 8 * 56 * 32;
    constexpr int NITEMS = I_IN + I_OUT + I_GLU + I_W1 + I_W3 + I_W2 + I_E1 + I_E3 + I_E2;
    for (int it = gw; it < NITEMS; it += NGW) {
        int r = it;
        if (r < I_IN) { const int l = r / (16 * 80), q = r % (16 * 80), kb = q / 80, nb = q % 80, n0 = 32 * nb;
            const float sc = ((n0 >= C_DQ && n0 < C_DK) || (n0 >= C_FQ && n0 < C_FK)) ? QSCALE : 1.0f;
            tr_item(argf(a, 3) + (size_t)l * D * INW, INW, D, (bf16_t*)(ws + W_WIN) + (size_t)l * ZW * D, 64 * kb, n0, n0, sc, scr, lane); continue; } r -= I_IN;
        if (r < I_OUT) { const int l = r / (16 * 32), q = r % (16 * 32), kb = q / 32, nb = q % 32;
            tr_item(argf(a, 4) + (size_t)l * D * D, D, D, (bf16_t*)(ws + W_WOUT) + (size_t)l * D * D, 64 * kb, 32 * nb, 32 * nb, 1.0f, scr, lane); continue; } r -= I_OUT;
        if (r < I_GLU) { const int l = r / 64, q = r % 64, kb = q / 16, nb = q % 16;
            tr_item(argf(a, 13) + (size_t)l * 256 * 512, 512, 256, (bf16_t*)(ws + W_WGLU) + (size_t)l * 512 * 256, 64 * kb, 32 * nb, 32 * nb, 1.0f, scr, lane); continue; } r -= I_GLU;
        if (r < I_W1 + I_W3) { const int which = r >= I_W1; if (which) r -= I_W1; const int kb = r / 88, nb = r % 88, n0 = 32 * nb;
            const int drow = 256 * (n0 / 128) + 128 * which + (n0 % 128);
            tr_item(argf(a, which ? 22 : 21), FFD, D, (bf16_t*)(ws + W_W13), 64 * kb, n0, drow, 1.0f, scr, lane); continue; } r -= I_W1 + I_W3;
        if (r < I_W2) { const int kb = r / 32, nb = r % 32;
            tr_item(argf(a, 23), D, FFD, (bf16_t*)(ws + W_W2), 64 * kb, 32 * nb, 32 * nb, 1.0f, scr, lane); continue; } r -= I_W2;
        if (r < I_E1 + I_E3) { const int which = r >= I_E1; if (which) r -= I_E1; const int e = r / (16 * 112), q = r % (16 * 112), kb = q / 112, nb = q % 112, n0 = 32 * nb;
            const int drow = 256 * (n0 / 128) + 128 * which + (n0 % 128);
            tr_item_fp8(argf(a, which ? 26 : 25) + (size_t)e * D * FFE, FFE, D, (unsigned char*)(ws + W_WE13) + (size_t)e * 2 * FFE * D, 64 * kb, n0, drow, WQ_SCALE, scr, lane); continue; } r -= I_E1 + I_E3;
        { const int e = r / (56 * 32), q = r % (56 * 32), kb = q / 32, nb = q % 32;
            tr_item_fp8(argf(a, 27) + (size_t)e * FFE * D, D, FFE, (unsigned char*)(ws + W_WE2) + (size_t)e * D * FFE, 64 * kb, 32 * nb, 32 * nb, WQ_SCALE, scr, lane); }
    }
    const int gt = gw * 64 + lane;
    if (gt < 2048) {
        const int l = gt >> 10, g = (gt >> 6) & 15, n = gt & 63;
        const float* lam_re = argf(a, 5) + l * 1024; const float* lam_im = argf(a, 6) + l * 1024; const float* log_dt = argf(a, 7) + l * 16;
        const double dt = exp_small((double)log_dt[g]);
        const double lr = (double)lam_re[g * 64 + n], li = (double)lam_im[g * 64 + n];
        const double mag = exp_small(lr * dt); double sn, cs; sincos_d(li * dt, sn, cs);
        const double ar = mag * cs, ai = mag * sn, den = lr * lr + li * li, nr = ar - 1.0, ni = ai;
        const float cre = (float)((nr * lr + ni * li) / den), cim = (float)((ni * lr - nr * li) / den);
        double pr = ar, pi = ai;
#pragma unroll
        for (int i = 0; i < 6; ++i) { const double t = pr * pr - pi * pi; pi = 2.0 * pr * pi; pr = t; }
        ((float2*)(ws + W_TAB + T_A))[gt] = make_float2((float)ar, (float)ai);
        ((float2*)(ws + W_TAB + T_A64))[gt] = make_float2((float)pr, (float)pi);
        const float* b_re = argf(a, 8) + (size_t)l * 16384 + (g * 64 + n) * 16; const float* b_im = argf(a, 9) + (size_t)l * 16384 + (g * 64 + n) * 16;
        bf16_t* bct = (bf16_t*)(ws + W_TAB + T_BCT) + (size_t)(l * 16 + g) * 128 * 16;
#pragma unroll
        for (int c = 0; c < 16; ++c) { const float r = b_re[c], i = b_im[c]; bct[n * 16 + c] = f2bf(cre * r - cim * i); bct[(64 + n) * 16 + c] = f2bf(cre * i + cim * r); }
        const float* c_re = argf(a, 10) + (size_t)l * 16384 + g * 1024; const float* c_im = argf(a, 11) + (size_t)l * 16384 + g * 1024;
        bf16_t* cct = (bf16_t*)(ws + W_TAB + T_CCT) + (size_t)(l * 16 + g) * 16 * 128;
#pragma unroll
        for (int c = 0; c < 16; ++c) { cct[c * 128 + n] = f2bf(c_re[c * 64 + n]); cct[c * 128 + 64 + n] = f2bf(-c_im[c * 64 + n]); }
    }
    if (gt < 2) {
        const int l = gt; float s1 = 0.f, s2 = 0.f;
        for (int i = 0; i < 64; ++i) { s1 += argf(a, 14)[l * 64 + i] * argf(a, 15)[l * 64 + i]; s2 += argf(a, 16)[l * 64 + i] * argf(a, 17)[l * 64 + i]; }
        const float lam_init = 0.8f - 0.6f * expf(-0.3f * (float)l);
        float* lamp = (float*)(ws + W_TAB + T_LAM); lamp[2 * l] = expf(s1) - expf(s2) + lam_init; lamp[2 * l + 1] = 1.0f - lam_init;
    }
}

__device__ __forceinline__ void norm_rows(const RowSrc& s, const float* g, const float* wfg, bf16_t* hbuf, float* fgbuf, int gw, int NGW, int lane, int nrows) {
    for (int r = gw; r < nrows; r += NGW) {
        unsigned long long* o8 = (unsigned long long*)(hbuf + (size_t)r * D) + lane;
        if (r >= MVALID) {
#pragma unroll
            for (int j = 0; j < 4; ++j) o8[64 * j] = 0ull;
            continue;
        }
        const float4* p = (const float4*)res_row(s, r) + lane;
        float4 v[4]; float ss = 0.f;
#pragma unroll
        for (int j = 0; j < 4; ++j) { v[j] = p[64 * j]; ss += v[j].x * v[j].x + v[j].y * v[j].y + v[j].z * v[j].z + v[j].w * v[j].w; }
        ss = wave_sum(ss);
        const float rstd = 1.0f / sqrtf(ss * (1.0f / D) + EPS);
#pragma unroll
        for (int j = 0; j < 4; ++j) {
            const float4 gj = ((const float4*)g)[lane + 64 * j];
            v[j].x = v[j].x * rstd * gj.x; v[j].y = v[j].y * rstd * gj.y; v[j].z = v[j].z * rstd * gj.z; v[j].w = v[j].w * rstd * gj.w;
            o8[64 * j] = (unsigned long long)cvtpk(v[j].x, v[j].y) | ((unsigned long long)cvtpk(v[j].z, v[j].w) << 32);
        }
        if (wfg) {
            float a[4] = {0.f, 0.f, 0.f, 0.f};
#pragma unroll
            for (int j = 0; j < 4; ++j) {
                const int k = 256 * j + 4 * lane;
                const float hv[4] = {v[j].x, v[j].y, v[j].z, v[j].w};
#pragma unroll
                for (int i = 0; i < 4; ++i) {
                    const float4 w = *(const float4*)(wfg + (size_t)(k + i) * INW);
                    a[0] += hv[i] * w.x; a[1] += hv[i] * w.y; a[2] += hv[i] * w.z; a[3] += hv[i] * w.w;
                }
            }
#pragma unroll
            for (int c = 0; c < 4; ++c) a[c] = wave_sum(a[c]);
            if (lane == 0) *(float4*)(fgbuf + (size_t)r * 4) = make_float4(a[0], a[1], a[2], a[3]);
        }
    }
}

namespace pg8 {
struct EpiSwiglu {
    static constexpr bool PERM = true, AFTER_DRAIN = false;
    bf16_t* H; int ldh; int pad;
    __device__ __forceinline__ void operator()(const f32x4 (&acc)[2][2][4][2], const Unit& u, int wr, int wc, int fr, int fq) const {
        const int row0 = u.pm * BM + wr * 64 + fr, col0 = u.pn * HALF + wc * 32 + 8 * fq;
#pragma unroll
        for (int ai = 0; ai < 2; ++ai)
#pragma unroll
            for (int m = 0; m < 4; ++m) {
                bf16_t* rowp = H + (size_t)(row0 + ai * HALF + m * 16) * ldh + col0;
                float h[8];
#pragma unroll
                for (int n = 0; n < 2; ++n)
#pragma unroll
                    for (int e = 0; e < 4; ++e) { const float x = acc[ai][0][m][n][e], y = acc[ai][1][m][n][e];
                        h[4 * n + e] = x * __builtin_amdgcn_rcpf(1.0f + __builtin_amdgcn_exp2f(-x * LOG2E)) * y; }
                u32x4 w; w.x = cvt_pk_bf16(h[0], h[1]); w.y = cvt_pk_bf16(h[2], h[3]); w.z = cvt_pk_bf16(h[4], h[5]); w.w = cvt_pk_bf16(h[6], h[7]);
                *(u32x4*)rowp = w;
            }
    }
};
struct EpiSwigluFp8 {
    static constexpr bool PERM = true, AFTER_DRAIN = false;
    unsigned char* H; int ldh; float sin;
    __device__ __forceinline__ void operator()(const f32x4 (&acc)[2][2][4][2], const Unit& u, int wr, int wc, int fr, int fq) const {
        const int row0 = u.pm * BM + wr * 64 + fr, col0 = u.pn * HALF + wc * 32 + 8 * fq;
#pragma unroll
        for (int ai = 0; ai < 2; ++ai)
#pragma unroll
            for (int m = 0; m < 4; ++m) {
                unsigned char* rowp = H + (size_t)(row0 + ai * HALF + m * 16) * ldh + col0;
                float h[8];
#pragma unroll
                for (int n = 0; n < 2; ++n)
#pragma unroll
                    for (int e = 0; e < 4; ++e) { const float x = acc[ai][0][m][n][e] * sin, y = acc[ai][1][m][n][e] * sin;
                        const float v = x * __builtin_amdgcn_rcpf(1.0f + __builtin_amdgcn_exp2f(-x * LOG2E)) * y * HQ_SCALE;
                        h[4 * n + e] = fminf(fmaxf(v, -448.0f), 448.0f); }
                u32x2 w; w.x = pk4_fp8(h[0], h[1], h[2], h[3]); w.y = pk4_fp8(h[4], h[5], h[6], h[7]);
                *(u32x2*)rowp = w;
            }
    }
};
struct EpiResF32 {
    static constexpr bool PERM = false, AFTER_DRAIN = false;
    RowSrc src; float* dout; float* resm;
    __device__ __forceinline__ void operator()(const f32x4 (&acc)[2][2][4][2], const Unit& u, int wr, int wc, int fr, int fq) const {
#pragma unroll
        for (int ai = 0; ai < 2; ++ai)
#pragma unroll
            for (int m = 0; m < 4; ++m) {
                const int r = u.pm * BM + ai * HALF + wr * 64 + m * 16 + fr;
                const float* bp = res_row(src, r); float* op = r < MAIN ? dout + (size_t)r * D : resm + (size_t)(r - MAIN) * D;
#pragma unroll
                for (int bj = 0; bj < 2; ++bj)
#pragma unroll
                    for (int n = 0; n < 2; ++n) { const int c = u.pn * BM + bj * HALF + wc * 32 + n * 16 + 4 * fq;
                        const f32x4 b = *(const f32x4*)(bp + c); *(f32x4*)(op + c) = b + acc[ai][bj][m][n]; }
            }
    }
};
template <bool GATH> struct MoeOrder : StaticOrder {
    static constexpr bool GATHER = GATH;
    int pb1, pb2, pb3, pb4, pb5, pb6, pb7;
    int c0, c1, c2, c3, c4, c5, c6, c7;
    size_t estride;
    const int* list;
    __device__ __forceinline__ int setup(const gu32* ecnt) {
        c0 = (int)__hip_atomic_load(ecnt + 0, RLX_AGENT); c1 = (int)__hip_atomic_load(ecnt + 64, RLX_AGENT); c2 = (int)__hip_atomic_load(ecnt + 128, RLX_AGENT); c3 = (int)__hip_atomic_load(ecnt + 192, RLX_AGENT);
        c4 = (int)__hip_atomic_load(ecnt + 256, RLX_AGENT); c5 = (int)__hip_atomic_load(ecnt + 320, RLX_AGENT); c6 = (int)__hip_atomic_load(ecnt + 384, RLX_AGENT); c7 = (int)__hip_atomic_load(ecnt + 448, RLX_AGENT);
        pb1 = (c0 + 255) >> 8; pb2 = pb1 + ((c1 + 255) >> 8); pb3 = pb2 + ((c2 + 255) >> 8); pb4 = pb3 + ((c3 + 255) >> 8);
        pb5 = pb4 + ((c4 + 255) >> 8); pb6 = pb5 + ((c5 + 255) >> 8); pb7 = pb6 + ((c6 + 255) >> 8);
        return pb7 + ((c7 + 255) >> 8);
    }
    __device__ __forceinline__ int pbase_of(int e) const { int r = 0; if (e == 1) r = pb1; if (e == 2) r = pb2; if (e == 3) r = pb3; if (e == 4) r = pb4; if (e == 5) r = pb5; if (e == 6) r = pb6; if (e == 7) r = pb7; return r; }
    __device__ __forceinline__ void locate(int pm, int& e, int& base, int& cnt) const {
        e = 0; base = 0; cnt = c0;
        if (pm >= pb1) { e = 1; base = pb1; cnt = c1; } if (pm >= pb2) { e = 2; base = pb2; cnt = c2; } if (pm >= pb3) { e = 3; base = pb3; cnt = c3; }
        if (pm >= pb4) { e = 4; base = pb4; cnt = c4; } if (pm >= pb5) { e = 5; base = pb5; cnt = c5; } if (pm >= pb6) { e = 6; base = pb6; cnt = c6; }
        if (pm >= pb7) { e = 7; base = pb7; cnt = c7; }
    }
    __device__ __forceinline__ const char* a_ptr(const Gemm& g, const Unit& u) const { return GATH ? (const char*)g.A : (const char*)g.A + (size_t)u.pm * ((size_t)BM * g.K * 2); }
    __device__ __forceinline__ const char* b_ptr(const Gemm& g, const Unit& u) const { int e, base, cnt; locate(u.pm, e, base, cnt); return (const char*)g.Bt + (size_t)e * estride + (size_t)u.pn * ((size_t)BM * g.K * 2); }
    __device__ __forceinline__ void gather_offs(const Gemm& g, const Unit& u, const int (&R)[2], const int (&C)[2], unsigned (&vo)[2][2]) const {
        int e, base, cnt; locate(u.pm, e, base, cnt);
        const int p0 = (u.pm - base) * BM;
#pragma unroll
        for (int h = 0; h < 2; ++h)
#pragma unroll
            for (int i = 0; i < 2; ++i) { const int p = p0 + h * HALF + R[i]; int tok = 0; if (p < cnt) tok = list[e * 16384 + p];
                vo[h][i] = (unsigned)(tok * g.K + C[i]) * 2u; }
    }
};
}

namespace att {
#define KSWZ(row, colB) ((row) * 256 + ((colB) ^ (((row) & 7) << 4)))
constexpr int SHM_V = 16384, SHM_K = 16384;
constexpr int L_V = 0, L_K = 2 * SHM_V, L_CK = 65536, L_WS = 65536 + 1024;
__device__ __forceinline__ int crow(int r, int hi) { return (r & 3) + 8 * (r >> 2) + 4 * hi; }
__device__ __forceinline__ int v_st(int k, int c) { const int kk = (k & ~0xC) | ((k & 4) << 1) | ((k & 8) >> 1); return ((kk >> 3) * 4 + (c >> 5)) * 512 + ((kk & 7) * 32 + (c & 31)) * 2; }
__device__ __forceinline__ int v_rd_base(int lane) { return ((lane & 3) << 3) | (((lane >> 2) & 3) << 6) | (((lane >> 4) & 1) << 5) | (((lane >> 5) & 1) << 8); }
constexpr int v_rd_off(int d0, int ks, int half) { return d0 * 512 + ks * 4096 + half * 2048; }
template <int OFF> __device__ __forceinline__ s16x4 tr_read(int vb) {
    s16x4 r; asm volatile("ds_read_b64_tr_b16 %0, %1 offset:%2" : "=&v"(r) : "v"(vb), "i"(OFF) : "memory"); return r;
}
template <int D0> __device__ __forceinline__ void pv_one(f32x16& od, int vb, bf16x8 pa0, bf16x8 pa1, bf16x8 pa2, bf16x8 pa3) {
    const s16x4 l0 = tr_read<v_rd_off(D0, 0, 0)>(vb), h0 = tr_read<v_rd_off(D0, 0, 1)>(vb), l1 = tr_read<v_rd_off(D0, 1, 0)>(vb), h1 = tr_read<v_rd_off(D0, 1, 1)>(vb);
    const s16x4 l2 = tr_read<v_rd_off(D0, 2, 0)>(vb), h2 = tr_read<v_rd_off(D0, 2, 1)>(vb), l3 = tr_read<v_rd_off(D0, 3, 0)>(vb), h3 = tr_read<v_rd_off(D0, 3, 1)>(vb);
    asm volatile("s_waitcnt lgkmcnt(0)" ::: "memory"); SBAR();
#define PK(L, H) (bf16x8){L[0], L[1], L[2], L[3], H[0], H[1], H[2], H[3]}
    od = __builtin_amdgcn_mfma_f32_32x32x16_bf16(pa0, PK(l0, h0), od, 0, 0, 0);
    od = __builtin_amdgcn_mfma_f32_32x32x16_bf16(pa1, PK(l1, h1), od, 0, 0, 0);
    od = __builtin_amdgcn_mfma_f32_32x32x16_bf16(pa2, PK(l2, h2), od, 0, 0, 0);
    od = __builtin_amdgcn_mfma_f32_32x32x16_bf16(pa3, PK(l3, h3), od, 0, 0, 0);
#undef PK
}

template <bool FOX>
__device__ __forceinline__ void attn_unit(int hsel, int b, int i, const bf16_t* z, const float* cum, float lam, float oml, const float* subg, bf16_t* mix, char* lds) {
    int tid_ = threadIdx.x; asm volatile("" : "+v"(tid_));
    const int tid = tid_, lane = tid & 63, r32 = lane & 31, hi = lane >> 5;
    const int wid = __builtin_amdgcn_readfirstlane(tid >> 6), half = wid >> 2, wq = wid & 3;
    const bool meta = (b == NB);
    const int qrow0 = meta ? MAIN : b * SEQ + 128 * i;
    const int kvmain0 = meta ? 0 : b * SEQ;
    const int nmain = meta ? 0 : 2 * i + 2, NT = nmain + 1;
    const int qcol = (FOX ? C_FQ : C_DQ) + 128 * hsel + 64 * half;
    const int kcol = (FOX ? C_FK : C_DK) + 128 * hsel, vcol = (FOX ? C_FV : C_DV) + 128 * hsel;
    const int qrel = 32 * wq + r32;
    const int qpos = meta ? qrel - 16 : 128 * i + qrel;
    float* wsf = (float*)(lds + L_WS) + wid * 64;
    float* ckb = (float*)(lds + L_CK);
    bf16x8 qr[4];
    {
        const bf16_t* Qw = z + (size_t)(qrow0 + qrel) * ZW + qcol + hi * 8;
#pragma unroll
        for (int d0 = 0; d0 < 4; ++d0) qr[d0] = *(const bf16x8*)(Qw + d0 * 16);
    }
    float cq = 0.f;
    if (FOX) cq = cum[(size_t)(qrow0 + qrel) * 4 + 2 * hsel + half];
    const int sr = tid >> 4, sc = (tid & 15) * 8, vst0 = v_st(sr, sc), vst1 = v_st(32 + sr, sc);
    const int vb0 = (int)(uintptr_t)(lds + L_V) + v_rd_base(lane);
    bf16x8 sk0, sk1, sv0, sv1; float sck = 0.f;
#define TROW(t) ((t) == 0 ? MAIN : kvmain0 + 64 * ((t) - 1))
#define SLOAD(t) do { const bf16_t* base_ = z + (size_t)(TROW(t) + sr) * ZW; \
        sk0 = *(const bf16x8*)(base_ + kcol + sc); sk1 = *(const bf16x8*)(base_ + (size_t)32 * ZW + kcol + sc); \
        sv0 = *(const bf16x8*)(base_ + vcol + sc); sv1 = *(const bf16x8*)(base_ + (size_t)32 * ZW + vcol + sc); \
        if (FOX && tid < 128) sck = cum[(size_t)(TROW(t) + (tid & 63)) * 4 + 2 * hsel + (tid >> 6)]; } while (0)
#define SWRITE(bf) do { *(bf16x8*)(lds + L_V + (bf) * SHM_V + vst0) = sv0; *(bf16x8*)(lds + L_V + (bf) * SHM_V + vst1) = sv1; \
        *(bf16x8*)(lds + L_K + (bf) * SHM_K + KSWZ(sr, sc * 2)) = sk0; *(bf16x8*)(lds + L_K + (bf) * SHM_K + KSWZ(32 + sr, sc * 2)) = sk1; \
        if (FOX && tid < 128) ckb[(bf) * 128 + tid] = sck; } while (0)
    float m_reg = -1e30f, l_reg = 0.f; f32x16 o[4];
#pragma unroll
    for (int d = 0; d < 4; ++d) o[d] = f32x16{};
    SLOAD(0); SWRITE(0); __syncthreads();
    for (int t = 0; t < NT; ++t) {
        const int bf = t & 1;
        if (t + 1 < NT) SLOAD(t + 1);
        f32x16 p0 = f32x16{}, p1 = f32x16{};
        {
            const char* Ks = lds + L_K + bf * SHM_K;
#pragma unroll
            for (int d0 = 0; d0 < 4; ++d0) { const int cb = ((4 * half + d0) * 16 + hi * 8) * 2;
                const bf16x8 b0 = *(const bf16x8*)(Ks + KSWZ(r32, cb)), b1 = *(const bf16x8*)(Ks + KSWZ(32 + r32, cb));
                p0 = __builtin_amdgcn_mfma_f32_32x32x16_bf16(b0, qr[d0], p0, 0, 0, 0);
                p1 = __builtin_amdgcn_mfma_f32_32x32x16_bf16(b1, qr[d0], p1, 0, 0, 0); }
        }
        if (FOX) {
            const float* ck = ckb + bf * 128 + half * 64;
#pragma unroll
            for (int g = 0; g < 4; ++g) { const float4 c0 = *(const float4*)(ck + 8 * g + 4 * hi), c1 = *(const float4*)(ck + 32 + 8 * g + 4 * hi);
                p0[4 * g + 0] += cq - c0.x; p0[4 * g + 1] += cq - c0.y; p0[4 * g + 2] += cq - c0.z; p0[4 * g + 3] += cq - c0.w;
                p1[4 * g + 0] += cq - c1.x; p1[4 * g + 1] += cq - c1.y; p1[4 * g + 2] += cq - c1.z; p1[4 * g + 3] += cq - c1.w; }
        }
        if (t == 0 || t - 1 >= 2 * i) {
            int lim; if (t == 0) { lim = qpos + 16; if (lim > 15) lim = 15; } else lim = qpos - 64 * (t - 1);
#pragma unroll
            for (int r = 0; r < 16; ++r) { const int kk = crow(r, hi); if (kk > lim) p0[r] = -INFINITY; if (kk + 32 > lim) p1[r] = -INFINITY; }
        }
        float pmax = p0[0];
#pragma unroll
        for (int r = 1; r < 16; ++r) pmax = fmaxf(pmax, p0[r]);
#pragma unroll
        for (int r = 0; r < 16; ++r) pmax = fmaxf(pmax, p1[r]);
        { auto rr = __builtin_amdgcn_permlane32_swap(__float_as_uint(pmax), __float_as_uint(pmax), false, false);
          pmax = fmaxf(__uint_as_float(rr[0]), __uint_as_float(rr[1])); }
        const float mn = fmaxf(m_reg, pmax);
        const float alpha = __builtin_amdgcn_exp2f(m_reg - mn); m_reg = mn;
        float ps = 0.f;
#pragma unroll
        for (int r = 0; r < 16; ++r) { p0[r] = __builtin_amdgcn_exp2f(p0[r] - mn); ps += p0[r]; }
#pragma unroll
        for (int r = 0; r < 16; ++r) { p1[r] = __builtin_amdgcn_exp2f(p1[r] - mn); ps += p1[r]; }
        { auto rr = __builtin_amdgcn_permlane32_swap(__float_as_uint(ps), __float_as_uint(ps), false, false);
          ps = __uint_as_float(rr[0]) + __uint_as_float(rr[1]); }
        l_reg = l_reg * alpha + ps;
        if (__any(alpha < 1.f)) {
            if (hi == 0) wsf[r32] = alpha;
            asm volatile("s_waitcnt lgkmcnt(0)" ::: "memory");
#pragma unroll
            for (int d = 0; d < 4; ++d)
#pragma unroll
                for (int r = 0; r < 16; ++r) o[d][r] *= wsf[crow(r, hi)];
            asm volatile("s_waitcnt lgkmcnt(0)" ::: "memory");
        }
        bf16x8 pa0, pa1, pa2, pa3;
#define PK4(P, BASE, OUT) do { unsigned a0 = cvtpk(P[BASE + 0], P[BASE + 1]), a1 = cvtpk(P[BASE + 2], P[BASE + 3]);   \
        unsigned b0 = cvtpk(P[BASE + 4], P[BASE + 5]), b1 = cvtpk(P[BASE + 6], P[BASE + 7]);                              \
        auto r0 = __builtin_amdgcn_permlane32_swap(a0, b0, false, false); auto r1 = __builtin_amdgcn_permlane32_swap(a1, b1, false, false); \
        u32x4 w = {r0[0], r1[0], r0[1], r1[1]}; OUT = *reinterpret_cast<bf16x8*>(&w); } while (0)
        PK4(p0, 0, pa0); PK4(p0, 8, pa1); PK4(p1, 0, pa2); PK4(p1, 8, pa3);
#undef PK4
        SBAR();
        const int vb = vb0 + bf * SHM_V;
        if (!FOX) { pv_one<0>(o[0], vb, pa0, pa1, pa2, pa3); pv_one<1>(o[1], vb, pa0, pa1, pa2, pa3); pv_one<2>(o[2], vb, pa0, pa1, pa2, pa3); pv_one<3>(o[3], vb, pa0, pa1, pa2, pa3); }
        else if (half == 0) { pv_one<0>(o[0], vb, pa0, pa1, pa2, pa3); pv_one<1>(o[1], vb, pa0, pa1, pa2, pa3); }
        else { pv_one<2>(o[0], vb, pa0, pa1, pa2, pa3); pv_one<3>(o[1], vb, pa0, pa1, pa2, pa3); }
        if (t + 1 < NT) SWRITE(bf ^ 1);
        __syncthreads();
    }
    if (hi == 0) wsf[32 + r32] = l_reg;
    asm volatile("s_waitcnt lgkmcnt(0)" ::: "memory");
    float rli[16];
#pragma unroll
    for (int r = 0; r < 16; ++r) rli[r] = 1.0f / wsf[32 + crow(r, hi)];
    const int nvalid = meta ? NMETA : 128;
    if (FOX) {
#pragma unroll
        for (int r = 0; r < 16; ++r) { const int rr = 32 * wq + crow(r, hi);
            if (rr < nvalid) {
                bf16_t* op = mix + (size_t)(qrow0 + rr) * D + 768 + 128 * hsel + 64 * half + r32;
                op[0] = f2bf(o[0][r] * rli[r]); op[32] = f2bf(o[1][r] * rli[r]); } }
    } else {
        float* xb = (float*)lds;
        if (half == 1) {
#pragma unroll
            for (int r = 0; r < 16; ++r) { const float f = rli[r] * lam; const int rr = 32 * wq + crow(r, hi);
#pragma unroll
                for (int d = 0; d < 4; ++d) xb[rr * 128 + 32 * d + r32] = o[d][r] * f; }
        }
        __syncthreads();
        if (half == 0) {
            float ssq[16];
#pragma unroll
            for (int r = 0; r < 16; ++r) { const int rr = 32 * wq + crow(r, hi); float s = 0.f;
#pragma unroll
                for (int d = 0; d < 4; ++d) { const float v = o[d][r] * rli[r] - xb[rr * 128 + 32 * d + r32]; o[d][r] = v; s += v * v; }
                ssq[r] = s; }
#pragma unroll
            for (int r = 0; r < 16; ++r) {
                float s = ssq[r];
                s += __shfl_xor(s, 1); s += __shfl_xor(s, 2); s += __shfl_xor(s, 4); s += __shfl_xor(s, 8); s += __shfl_xor(s, 16);
                ssq[r] = oml / sqrtf(s * (1.0f / 128.0f) + EPS);
            }
            float gsub[4];
#pragma unroll
            for (int d = 0; d < 4; ++d) gsub[d] = subg[32 * d + r32];
#pragma unroll
            for (int r = 0; r < 16; ++r) { const int rr = 32 * wq + crow(r, hi);
                if (rr < nvalid) {
                    bf16_t* op = mix + (size_t)(qrow0 + rr) * D + 256 + 128 * hsel + r32;
#pragma unroll
                    for (int d = 0; d < 4; ++d) op[32 * d] = f2bf(o[d][r] * ssq[r] * gsub[d]); } }
        }
        __syncthreads();
    }
#undef TROW
#undef SLOAD
#undef SWRITE
}
#undef KSWZ
}

namespace ssm {
constexpr int UST = 528;
constexpr int L_U = 0, L_W = 33792, WREG = 12800, L_BW = 0, BWST = 132  , L_X = 8448, XST = 272;
template <bool PASS_C>
__device__ __forceinline__ void ssm_unit(int l, int b, int c, const bf16_t* z, const unsigned char* tab, float2* Sbuf, float2* Smeta, const float* dskip, const bf16_t* wglu_t, bf16_t* mix, char* lds) {
    int tid_ = threadIdx.x; asm volatile("" : "+v"(tid_));
    const int tid = tid_, lane = tid & 63, fr = lane & 15, fq = lane >> 4;
    const int wid = __builtin_amdgcn_readfirstlane(tid >> 6);
    const bool meta = (b == NB);
    const int row0 = meta ? MAIN : b * SEQ + 64 * c;
    const int nsb = meta ? 1 : 4;
    {
        const int row = tid >> 3;
#pragma unroll
        for (int q = 0; q < 4; ++q) { const int c16 = (tid & 7) + 8 * q;
            const bf16x8 v = *(const bf16x8*)(z + (size_t)(row0 + row) * ZW + c16 * 8);
            *(bf16x8*)(lds + L_U + row * UST + c16 * 16) = v; }
    }
    __syncthreads();
    char* wreg = lds + L_W + wid * WREG;
    float* bw = (float*)(wreg + L_BW);
    char* xw = wreg + L_X;
    const float2* Atab = (const float2*)(tab + T_A) + l * 1024;
    const float2* A64tab = (const float2*)(tab + T_A64) + l * 1024;
    const bf16_t* Bct = (const bf16_t*)(tab + T_BCT) + (size_t)l * 16 * 128 * 16;
    const bf16_t* Cct = (const bf16_t*)(tab + T_CCT) + (size_t)l * 16 * 16 * 128;
    for (int gi = 0; gi < 2; ++gi) {
        const int g = wid * 2 + gi;
        const float2 A = Atab[g * 64 + lane];
        bf16x8 Bf[8];
#pragma unroll
        for (int tl = 0; tl < 8; ++tl) { Bf[tl] = bf16x8{}; if (fq < 2) Bf[tl] = *(const bf16x8*)(Bct + (size_t)(g * 128 + 16 * tl + fr) * 16 + 8 * fq); }
        bf16x8 Cf[4]; float dsk[4];
        if (PASS_C) {
#pragma unroll
            for (int ks = 0; ks < 4; ++ks) Cf[ks] = *(const bf16x8*)(Cct + (size_t)(g * 16 + fr) * 128 + 32 * ks + 8 * fq);
#pragma unroll
            for (int e = 0; e < 4; ++e) dsk[e] = dskip[g * 16 + 4 * fq + e];
        }
        float xr = 0.f, xi = 0.f;
        if (PASS_C && !meta) {
            const float2 A64 = A64tab[g * 64 + lane];
            const float2 sm = Smeta[g * 64 + lane]; xr = sm.x; xi = sm.y;
            for (int j = 0; j < c; ++j) { const float2 s = Sbuf[((size_t)(b * 32 + j) * 16 + g) * 64 + lane];
                const float nr = A64.x * xr - A64.y * xi + s.x, ni = A64.x * xi + A64.y * xr + s.y; xr = nr; xi = ni; }
        }
        for (int sb = 0; sb < nsb; ++sb) {
            bf16x8 ua = bf16x8{};
            if (fq < 2) ua = *(const bf16x8*)(lds + L_U + (16 * sb + fr) * UST + (16 * g + 8 * fq) * 2);
#pragma unroll
            for (int tl = 0; tl < 8; ++tl) {
                f32x4 acc = {0.f, 0.f, 0.f, 0.f};
                acc = __builtin_amdgcn_mfma_f32_16x16x32_bf16(ua, Bf[tl], acc, 0, 0, 0);
#pragma unroll
                for (int e = 0; e < 4; ++e) bw[(4 * fq + e) * BWST + 16 * tl + fr] = acc[e];
            }
            asm volatile("s_waitcnt lgkmcnt(0)" ::: "memory");
#pragma unroll
            for (int t = 0; t < 16; ++t) {
                const float re = bw[t * BWST + lane], im = bw[t * BWST + 64 + lane];
                const float nr = A.x * xr - A.y * xi + re, ni = A.x * xi + A.y * xr + im; xr = nr; xi = ni;
                if (PASS_C) { ((bf16_t*)(xw + t * XST))[lane] = f2bf(xr); ((bf16_t*)(xw + t * XST))[64 + lane] = f2bf(xi); }
            }
            asm volatile("s_waitcnt lgkmcnt(0)" ::: "memory");
            if (PASS_C) {
                f32x4 acc = {0.f, 0.f, 0.f, 0.f};
#pragma unroll
                for (int ks = 0; ks < 4; ++ks) { const bf16x8 xb = *(const bf16x8*)(xw + fr * XST + (32 * ks + 8 * fq) * 2);
                    acc = __builtin_amdgcn_mfma_f32_16x16x32_bf16(Cf[ks], xb, acc, 0, 0, 0); }
                u32x2* up = (u32x2*)(lds + L_U + (16 * sb + fr) * UST + (16 * g + 4 * fq) * 2);
                const u32x2 uu = *up;
                const float u0 = __uint_as_float(uu.x << 16), u1 = __uint_as_float(uu.x & 0xffff0000u), u2 = __uint_as_float(uu.y << 16), u3 = __uint_as_float(uu.y & 0xffff0000u);
                const float y0 = gelu_tanh(acc[0] + dsk[0] * u0), y1 = gelu_tanh(acc[1] + dsk[1] * u1), y2 = gelu_tanh(acc[2] + dsk[2] * u2), y3 = gelu_tanh(acc[3] + dsk[3] * u3);
                u32x2 w; w.x = cvtpk(y0, y1); w.y = cvtpk(y2, y3); *up = w;
                asm volatile("s_waitcnt lgkmcnt(0)" ::: "memory");
            }
        }
        if (!PASS_C) {
            if (meta) Smeta[g * 64 + lane] = make_float2(xr, xi);
            else Sbuf[((size_t)(b * 32 + c) * 16 + g) * 64 + lane] = make_float2(xr, xi);
        }
    }
    __syncthreads();
    if (PASS_C) {
        const int r32 = lane & 31, hi = lane >> 5;
        f32x16 a00 = f32x16{}, a01 = f32x16{}, a10 = f32x16{}, a11 = f32x16{};
        const bf16_t* w1p = wglu_t + (size_t)(32 * wid + r32) * 256 + 8 * hi;
        const bf16_t* w2p = wglu_t + (size_t)(256 + 32 * wid + r32) * 256 + 8 * hi;
#pragma unroll 4
        for (int ks = 0; ks < 16; ++ks) {
            const bf16x8 wa = *(const bf16x8*)(w1p + 16 * ks), wb = *(const bf16x8*)(w2p + 16 * ks);
            const bf16x8 y0 = *(const bf16x8*)(lds + L_U + r32 * UST + (16 * ks + 8 * hi) * 2), y1 = *(const bf16x8*)(lds + L_U + (32 + r32) * UST + (16 * ks + 8 * hi) * 2);
            a00 = __builtin_amdgcn_mfma_f32_32x32x16_bf16(wa, y0, a00, 0, 0, 0); a01 = __builtin_amdgcn_mfma_f32_32x32x16_bf16(wa, y1, a01, 0, 0, 0);
            a10 = __builtin_amdgcn_mfma_f32_32x32x16_bf16(wb, y0, a10, 0, 0, 0); a11 = __builtin_amdgcn_mfma_f32_32x32x16_bf16(wb, y1, a11, 0, 0, 0);
        }
        const int nvalid = meta ? NMETA : 64;
#pragma unroll
        for (int tt = 0; tt < 2; ++tt) {
            const int t = 32 * tt + r32;
            if (t < nvalid) {
#pragma unroll
                for (int q = 0; q < 4; ++q) {
                    float v[4];
#pragma unroll
                    for (int e = 0; e < 4; ++e) { const float a = tt ? a01[4 * q + e] : a00[4 * q + e], gte = tt ? a11[4 * q + e] : a10[4 * q + e];
                        v[e] = a * __builtin_amdgcn_rcpf(1.0f + __builtin_amdgcn_exp2f(-gte * LOG2E)); }
                    u32x2 w; w.x = cvtpk(v[0], v[1]); w.y = cvtpk(v[2], v[3]);
                    *(u32x2*)(mix + (size_t)(row0 + t) * D + 32 * wid + 8 * q + 4 * hi) = w;
                }
            }
        }
        __syncthreads();
    }
}
__device__ __forceinline__ float wave_incl_scan(float v, int lane) {
#pragma unroll
    for (int o = 1; o < 64; o <<= 1) { const float t = __shfl_up(v, o); if (lane >= o) v += t; }
    return v;
}
__device__ __forceinline__ void cum_wave(int b, int h, const float* fg, float bias, float* cum, int lane) {
    float vm = 0.f; if (lane < NMETA) vm = log_sigmoid(fg[(size_t)(MAIN + lane) * 4 + h] + bias);
    const float cm = wave_incl_scan(vm, lane);
    const float tot_meta = __shfl(cm, 63);
    if (b == 0 && lane < NMETA) cum[(size_t)(MAIN + lane) * 4 + h] = cm * LOG2E;
    float f[32]; float s = 0.f;
#pragma unroll
    for (int i = 0; i < 32; ++i) { f[i] = log_sigmoid(fg[(size_t)(b * SEQ + 32 * lane + i) * 4 + h] + bias); s += f[i]; }
    const float inc = wave_incl_scan(s, lane);
    float run = tot_meta + (inc - s);
#pragma unroll
    for (int i = 0; i < 32; ++i) { run += f[i]; cum[(size_t)(b * SEQ + 32 * lane + i) * 4 + h] = run * LOG2E; }
}
}

__device__ __forceinline__ void router_block(int blk, const RowSrc& s, const float* g, const float* wr, bf16_t* hbuf, gu32* ecnt, int* list, int* tokinfo, LAS unsigned char* lds, int wave, int lane) {
    LAS int* wc = (LAS int*)lds;
    LAS int* bb = (LAS int*)(lds + 256);
    int e1s[8], e2s[8]; float g1s[8];
    int cnt[8];
#pragma unroll
    for (int e = 0; e < 8; ++e) cnt[e] = 0;
#pragma unroll
    for (int it = 0; it < 8; ++it) {
        const int r = blk * 64 + wave * 8 + it;
        unsigned* o4 = (unsigned*)((unsigned char*)hbuf + (size_t)r * D) + lane;
        const float4* p = (const float4*)res_row(s, r) + lane;
        float4 v[4]; float ss = 0.f;
#pragma unroll
        for (int j = 0; j < 4; ++j) { v[j] = p[64 * j]; ss += v[j].x * v[j].x + v[j].y * v[j].y + v[j].z * v[j].z + v[j].w * v[j].w; }
        ss = wave_sum(ss);
        const float rstd = 1.0f / sqrtf(ss * (1.0f / D) + EPS);
        float a[8];
#pragma unroll
        for (int e = 0; e < 8; ++e) a[e] = 0.f;
#pragma unroll
        for (int j = 0; j < 4; ++j) {
            const float4 gj = ((const float4*)g)[lane + 64 * j];
            v[j].x = v[j].x * rstd * gj.x; v[j].y = v[j].y * rstd * gj.y; v[j].z = v[j].z * rstd * gj.z; v[j].w = v[j].w * rstd * gj.w;
            o4[64 * j] = pk4_fp8(v[j].x, v[j].y, v[j].z, v[j].w);
            const int k = 256 * j + 4 * lane;
            const float hv[4] = {v[j].x, v[j].y, v[j].z, v[j].w};
#pragma unroll
            for (int i = 0; i < 4; ++i) {
                const float4 w0 = *(const float4*)(wr + (size_t)(k + i) * 8), w1 = *(const float4*)(wr + (size_t)(k + i) * 8 + 4);
                a[0] += hv[i] * w0.x; a[1] += hv[i] * w0.y; a[2] += hv[i] * w0.z; a[3] += hv[i] * w0.w;
                a[4] += hv[i] * w1.x; a[5] += hv[i] * w1.y; a[6] += hv[i] * w1.z; a[7] += hv[i] * w1.w;
            }
        }
#pragma unroll
        for (int e = 0; e < 8; ++e) a[e] = wave_sum(a[e]);
        int i1 = 0; float v1 = a[0];
#pragma unroll
        for (int e = 1; e < 8; ++e) if (a[e] > v1) { v1 = a[e]; i1 = e; }
        int i2 = 0; float v2 = -3.0e38f;
#pragma unroll
        for (int e = 0; e < 8; ++e) if (e != i1 && a[e] > v2) { v2 = a[e]; i2 = e; }
        e1s[it] = i1; e2s[it] = i2; g1s[it] = 1.0f / (1.0f + expf(v2 - v1));
#pragma unroll
        for (int e = 0; e < 8; ++e) cnt[e] += (e == i1) + (e == i2);
    }
    if (lane < 8) { int c = 0;
#pragma unroll
        for (int e = 0; e < 8; ++e) if (lane == e) c = cnt[e];
        wc[wave * 8 + lane] = c; }
    LDS_WAIT(); __syncthreads();
    if (wave == 0 && lane < 8) { int tot = 0;
#pragma unroll
        for (int w = 0; w < 8; ++w) tot += wc[w * 8 + lane];
        bb[lane] = (int)__hip_atomic_fetch_add(ecnt + 64 * lane, (unsigned)tot, RLX_AGENT); }
    LDS_WAIT(); __syncthreads();
    int off[8];
#pragma unroll
    for (int e = 0; e < 8; ++e) { int o = bb[e]; for (int w = 0; w < 8; ++w) if (w < wave) o += wc[w * 8 + e]; off[e] = o; }
#pragma unroll
    for (int it = 0; it < 8; ++it) {
        const int r = blk * 64 + wave * 8 + it;
        int p1 = 0, p2 = 0;
#pragma unroll
        for (int e = 0; e < 8; ++e) { if (e == e1s[it]) { p1 = off[e]; off[e] += 1; } }
#pragma unroll
        for (int e = 0; e < 8; ++e) { if (e == e2s[it]) { p2 = off[e]; off[e] += 1; } }
        if (lane == 0) {
            list[e1s[it] * 16384 + p1] = r; list[e2s[it] * 16384 + p2] = r;
            int4 ti; ti.x = e1s[it] | (e2s[it] << 8); ti.y = p1; ti.z = p2; ti.w = (int)__float_as_uint(g1s[it]);
            *(int4*)(tokinfo + (size_t)r * 4) = ti;
        }
    }
    __syncthreads();
}


template <int K>
__device__ __forceinline__ void meta_rows_gemm(int nb, const bf16_t* A, const bf16_t* Bt, const float* base, int base_ld, float* outp, char* lds) {
    int tid_ = threadIdx.x; asm volatile("" : "+v"(tid_));
    const int tid = tid_, lane = tid & 63, fr = lane & 15, fq = lane >> 4;
    const int wid = __builtin_amdgcn_readfirstlane(tid >> 6);
    constexpr int KW = K / 8, NS = KW / 32;
    const bf16_t* ap = A + (size_t)(MAIN + fr) * K + wid * KW + 8 * fq;
    const bf16_t* bp = Bt + (size_t)(16 * nb + fr) * K + wid * KW + 8 * fq;
    f32x4 acc = {0.f, 0.f, 0.f, 0.f};
#pragma unroll
    for (int s = 0; s < NS; ++s) {
        const bf16x8 a = *(const bf16x8*)(ap + 32 * s), b = *(const bf16x8*)(bp + 32 * s);
        acc = __builtin_amdgcn_mfma_f32_16x16x32_bf16(a, b, acc, 0, 0, 0);
    }
    float* red = (float*)lds;
#pragma unroll
    for (int e = 0; e < 4; ++e) red[wid * 256 + (4 * fq + e) * 16 + fr] = acc[e];
    __syncthreads();
    if (tid < 256) {
        const int r = tid >> 4, c = tid & 15; float v = 0.f;
#pragma unroll
        for (int w = 0; w < 8; ++w) v += red[w * 256 + tid];
        outp[(size_t)r * D + 16 * nb + c] = base[(size_t)r * base_ld + 16 * nb + c] + v;
    }
    __syncthreads();
}
__device__ __forceinline__ RowSrc mk_src(const MkArgs& args, int layer0) {
    RowSrc s{}; s.x = argf(args, 0); s.meta = argf(args, 1); s.dout = argout(args); s.resm = (const float*)(argws(args) + W_RESM); s.layer0 = layer0; s.pad = 0; return s;
}
__global__ void __launch_bounds__(NWAVES * 64, 2) mk_fwd(MkArgs args) {
    extern __shared__ __attribute__((aligned(16))) unsigned char lds_raw[];
    LAS unsigned char* lds = (LAS unsigned char*)lds_raw;
    volatile LAS unsigned* MISC = (volatile LAS unsigned*)(lds + MISC_OFF);
    const int tid = threadIdx.x;
    const int G = gridDim.x, bx = blockIdx.x;
    const int vcu = (G % 8 == 0) ? (bx % 8) * (G / 8) + bx / 8 : bx;
    const int NGW = G * NWAVES;
    for (int u = tid; u < (LDS_BYTES - LDSCTL_OFF) / 4; u += NWAVES * 64) ((LAS unsigned*)(lds + LDSCTL_OFF))[u] = 0u;
    __syncthreads();
    (void)xcd_barrier_post((unsigned*)((gu32*)(argws(args) + W_CTL) + CW_BAR), MISC + 8);
#ifndef PH_MASK
#define PH_MASK 0x1FFFF
#endif
#define IN(k) (((PH_MASK >> (k)) & 1) && argi(args, 0) <= (k) && (k) < argi(args, 1))
#define SEAM(k) do { if (IN(k) && IN((k) + 1)) { XcdBarrier bar_; bar_.bar = (unsigned*)((gu32*)(argws(args) + W_CTL) + CW_BAR); bar_.x = xb_xcc_id(); bar_.st = (volatile LAS unsigned*)(lds + MISC_OFF) + 8; xcd_barrier(bar_); } } while (0)
#define WSP(T, off) ((T*)(argws(args) + (off)))
#ifndef REPEAT_MASK
#define REPEAT_MASK 0
#endif
#define GBAR() do { XcdBarrier bar_; bar_.bar = (unsigned*)((gu32*)(argws(args) + W_CTL) + CW_BAR); bar_.x = xb_xcc_id(); bar_.st = (volatile LAS unsigned*)(lds + MISC_OFF) + 8; xcd_barrier(bar_); } while (0)
#define PH_BEGIN(k) if (IN(k)) for (int rep = 0; rep < ((((REPEAT_MASK) >> (k)) & 1) ? 2 : 1); ++rep) { if (rep) GBAR();
#define PH_END() }
#define FRESH() int tid_f = threadIdx.x; asm volatile("" : "+v"(tid_f)); const int lane_f = tid_f & 63, wave_f = __builtin_amdgcn_readfirstlane(tid_f >> 6), gw_f = vcu * NWAVES + wave_f; (void)lane_f; (void)gw_f

    PH_BEGIN(0) {
        FRESH();
        p0_prologue(args, lds, gw_f, NGW, wave_f, lane_f);
        norm_rows(mk_src(args, 1), argf(args, 2), argf(args, 3) + ZW, WSP(bf16_t, W_H), WSP(float, W_FG), gw_f, NGW, lane_f, MP);
    } PH_END()
    SEAM(0);
#pragma unroll 1
    for (int l = 0; l < 2; ++l) {
        const int pb = 1 + 8 * l;
        PH_BEGIN(pb + 0) {
            pg8::Gemm g{WSP(bf16_t, W_H), WSP(bf16_t, W_WIN) + (size_t)l * ZW * D, MP, ZW, D};
            pg8::StaticOrder S; S.init(MP, ZW, G, bx);
            pg8::EpiBf16<0> E{WSP(bf16_t, W_Z), ZW, nullptr, 0, 0, 1.f};
            pg8::gemm_phase<pg8::EpiBf16<0>, pg8::StaticOrder, true, true>(lds, g, S, E);
        } PH_END()
        SEAM(pb + 0);
        PH_BEGIN(pb + 1) {
            if (!(argi(args, 2) & 1)) for (int u = bx; u < 257; u += G)
                ssm::ssm_unit<false>(l, u < 256 ? u / 32 : NB, u % 32, WSP(bf16_t, W_Z), argws(args) + W_TAB, WSP(float2, W_TAB + T_S), WSP(float2, W_TAB + T_SMETA), nullptr, nullptr, nullptr, (char*)lds_raw);
            { FRESH(); if (wave_f < 4) for (int b = bx; b < NB; b += G) ssm::cum_wave(b, wave_f, WSP(float, W_FG), argf(args, 19)[l * 4 + wave_f], WSP(float, W_CUM), lane_f); }
        } PH_END()
        SEAM(pb + 1);
        PH_BEGIN(pb + 2) {
#ifndef NO_SSMC
            if (!(argi(args, 2) & 1))
                for (int u = bx; u < 257; u += G)
                    ssm::ssm_unit<true>(l, u < 256 ? u / 32 : NB, u % 32, WSP(bf16_t, W_Z), argws(args) + W_TAB, WSP(float2, W_TAB + T_S), WSP(float2, W_TAB + T_SMETA), argf(args, 12) + l * 256,
                                        WSP(bf16_t, W_WGLU) + (size_t)l * 512 * 256, WSP(bf16_t, W_MIX), (char*)lds_raw);
#endif
            if (!(argi(args, 2) & 2)) {
                gu32* ctl = (gu32*)(argws(args) + W_CTL);
#ifndef NO_ATTD
                for (;;) {
                    if (tid == 0) MISC[16] = __hip_atomic_fetch_add(ctl + CW_QCTR + 64 * (2 * l) + 512 * rep, 1u, RLX_AGENT);
                    __syncthreads();
                    const int u = (int)MISC[16];
                    __syncthreads();
                    if (u >= 516) break;
                    const int i = u < 512 ? 15 - (u >> 5) : 0, w = u & 31;
                    const float* lamp = WSP(float, W_TAB + T_LAM);
                    att::attn_unit<false>(w & 3, u < 512 ? (w >> 2) : NB, i, WSP(bf16_t, W_Z), WSP(float, W_CUM), lamp[2 * l], lamp[2 * l + 1], argf(args, 18) + l * 128, WSP(bf16_t, W_MIX), (char*)lds_raw);
                }
#endif
#ifndef NO_ATTF
                for (;;) {
                    if (tid == 0) MISC[17] = __hip_atomic_fetch_add(ctl + CW_QCTR + 64 * (2 * l + 1) + 512 * rep, 1u, RLX_AGENT);
                    __syncthreads();
                    const int u = (int)MISC[17];
                    __syncthreads();
                    if (u >= 258) break;
                    const int i = u < 256 ? 15 - (u >> 4) : 0, w = u & 15;
                    att::attn_unit<true>(w & 1, u < 256 ? (w >> 1) : NB, i, WSP(bf16_t, W_Z), WSP(float, W_CUM), 0.f, 0.f, nullptr, WSP(bf16_t, W_MIX), (char*)lds_raw);
                }
#endif
            }
        } PH_END()
        SEAM(pb + 2);
        PH_BEGIN(pb + 3) {
            pg8::Gemm g{WSP(bf16_t, W_MIX), WSP(bf16_t, W_WOUT) + (size_t)l * D * D, MAIN, D, D};
            pg8::StaticOrder S; S.init(MAIN, D, G, bx);
            pg8::EpiResF32 E{mk_src(args, l == 0), argout(args), WSP(float, W_RESM)};
            pg8::gemm_phase<pg8::EpiResF32, pg8::StaticOrder, true, true>(lds, g, S, E);
            if (l == 0) for (int nb = bx; nb < 64; nb += G) meta_rows_gemm<D>(nb, WSP(bf16_t, W_MIX), WSP(bf16_t, W_WOUT), argf(args, 1), D, WSP(float, W_RESM), (char*)lds_raw);
        } PH_END()
        SEAM(pb + 3);
        if (l == 0) {
            if (IN(pb + 4)) { FRESH(); norm_rows(mk_src(args, 0), argf(args, 20), nullptr, WSP(bf16_t, W_H), nullptr, gw_f, NGW, lane_f, MP); }
            SEAM(pb + 4);
            PH_BEGIN(pb + 5) {
                pg8::Gemm g{WSP(bf16_t, W_H), WSP(bf16_t, W_W13), MP, 2 * FFD, D};
                pg8::StaticOrder S; S.init(MP, 2 * FFD, G, bx);
                pg8::EpiSwiglu E{WSP(bf16_t, W_HD), FFD, 0};
                pg8::gemm_phase<pg8::EpiSwiglu, pg8::StaticOrder, true, true>(lds, g, S, E);
            } PH_END()
            SEAM(pb + 5);
            PH_BEGIN(pb + 6) {
                pg8::Gemm g{WSP(bf16_t, W_HD), WSP(bf16_t, W_W2), MAIN, D, FFD};
                pg8::StaticOrder S; S.init(MAIN, D, G, bx);
                pg8::EpiResF32 E{mk_src(args, 0), argout(args), WSP(float, W_RESM)};
                pg8::gemm_phase<pg8::EpiResF32, pg8::StaticOrder, true, true>(lds, g, S, E);
                for (int nb = bx; nb < 64; nb += G) meta_rows_gemm<FFD>(nb, WSP(bf16_t, W_HD), WSP(bf16_t, W_W2), WSP(float, W_RESM), D, WSP(float, W_RESM), (char*)lds_raw);
            } PH_END()
            SEAM(pb + 6);
            if (IN(pb + 7)) { FRESH(); norm_rows(mk_src(args, 0), argf(args, 2) + D, argf(args, 3) + (size_t)D * INW + ZW, WSP(bf16_t, W_H), WSP(float, W_FG), gw_f, NGW, lane_f, MP); }
            SEAM(pb + 7);
        } else {
            if (IN(pb + 4)) { FRESH(); for (int blk = bx; blk < MAIN / 64; blk += G) router_block(blk, mk_src(args, 0), argf(args, 20) + D, argf(args, 24), WSP(bf16_t, W_H), (gu32*)(argws(args) + W_CTL) + CW_ECNT, WSP(int, W_LIST), WSP(int, W_TOK), lds, wave_f, lane_f); }
            SEAM(pb + 4);
            PH_BEGIN(pb + 5) {
                pg8::MoeOrder<true> S; const int P = S.setup((gu32*)(argws(args) + W_CTL) + CW_ECNT);
                pg8::Gemm g{WSP(bf16_t, W_H), WSP(bf16_t, W_WE13), P * 256, 2 * FFE, D / 2};
                S.init(P * 256, 2 * FFE, G, bx); S.estride = (size_t)2 * FFE * D; S.list = WSP(int, W_LIST);
                pg8::EpiSwigluFp8 E{WSP(unsigned char, W_HM), FFE, 1.0f / WQ_SCALE};
                pg8::gemm_phase<pg8::EpiSwigluFp8, pg8::MoeOrder<true>, true, true, true>(lds, g, S, E);
            } PH_END()
            SEAM(pb + 5);
            PH_BEGIN(pb + 6) {
                pg8::MoeOrder<false> S; const int P = S.setup((gu32*)(argws(args) + W_CTL) + CW_ECNT);
                pg8::Gemm g{WSP(bf16_t, W_HM), WSP(bf16_t, W_WE2), P * 256, D, FFE / 2};
                S.init(P * 256, D, G, bx); S.estride = (size_t)D * FFE; S.list = WSP(int, W_LIST);
                pg8::EpiBf16<0> E{WSP(bf16_t, W_YM), D, nullptr, 1 << 30, 0, 1.0f / (WQ_SCALE * HQ_SCALE)};
                pg8::gemm_phase<pg8::EpiBf16<0>, pg8::MoeOrder<false>, true, true, true>(lds, g, S, E);
            } PH_END()
            SEAM(pb + 6);
            if (IN(pb + 7)) {
                FRESH(); const int gw = gw_f, lane = lane_f;
                pg8::MoeOrder<false> S; (void)S.setup((gu32*)(argws(args) + W_CTL) + CW_ECNT);
                const bf16_t* Y = WSP(bf16_t, W_YM); const float* gf = argf(args, 28); const int* tokinfo = WSP(int, W_TOK); float* dout = argout(args);
                for (int r = gw; r < MAIN; r += NGW) {
                    const int4 ti = *(const int4*)(tokinfo + (size_t)r * 4);
                    const int e1 = ti.x & 255, e2 = (ti.x >> 8) & 255; const float g1 = __uint_as_float((unsigned)ti.w), g2 = 1.0f - g1;
                    const int s1 = S.pbase_of(e1) * 256 + ti.y, s2 = S.pbase_of(e2) * 256 + ti.z;
                    float4* p = (float4*)(dout + (size_t)r * D) + lane;
                    const u32x2* y1 = (const u32x2*)(Y + (size_t)s1 * D) + lane; const u32x2* y2 = (const u32x2*)(Y + (size_t)s2 * D) + lane;
                    float4 v[4]; float ss = 0.f;
#pragma unroll
                    for (int j = 0; j < 4; ++j) { v[j] = p[64 * j]; const u32x2 a = y1[64 * j], b = y2[64 * j];
                        v[j].x += g1 * __uint_as_float(a.x << 16) + g2 * __uint_as_float(b.x << 16);
                        v[j].y += g1 * __uint_as_float(a.x & 0xffff0000u) + g2 * __uint_as_float(b.x & 0xffff0000u);
                        v[j].z += g1 * __uint_as_float(a.y << 16) + g2 * __uint_as_float(b.y << 16);
                        v[j].w += g1 * __uint_as_float(a.y & 0xffff0000u) + g2 * __uint_as_float(b.y & 0xffff0000u);
                        ss += v[j].x * v[j].x + v[j].y * v[j].y + v[j].z * v[j].z + v[j].w * v[j].w; }
                    ss = wave_sum(ss);
                    const float rstd = 1.0f / sqrtf(ss * (1.0f / D) + EPS);
#pragma unroll
                    for (int j = 0; j < 4; ++j) { const float4 gj = ((const float4*)gf)[lane + 64 * j];
                        p[64 * j] = make_float4(v[j].x * rstd * gj.x, v[j].y * rstd * gj.y, v[j].z * rstd * gj.z, v[j].w * rstd * gj.w); }
                }
            }
        }
    }
#undef IN
#undef SEAM
#undef WSP
}

#ifndef OPT_MASK
#define OPT_MASK 0x3FF
#endif
#ifndef ONE_LAUNCH
#define ONE_LAUNCH 1
#endif
extern "C" void kernel_launch(void* const* d_in, const int* in_sizes, int n_in, void* d_out, int out_size, void* d_ws, size_t ws_size, hipStream_t stream) {
    static int grid = 0;
    if (grid == 0) {
        int dev = 0, cus = 0;
        if (n_in != 29 || out_size != MAIN * D || ws_size < W_END) { fprintf(stderr, "kernel_launch: unexpected shapes (n_in %d out %d ws %zu)\n", n_in, out_size, ws_size); grid = -1; return; }
        if (hipGetDevice(&dev) != hipSuccess || hipDeviceGetAttribute(&cus, hipDeviceAttributeMultiprocessorCount, dev) != hipSuccess) { grid = -1; return; }
        if (hipFuncSetAttribute((const void*)mk_fwd, hipFuncAttributeMaxDynamicSharedMemorySize, LDS_BYTES) != hipSuccess) { grid = -1; return; }
        int per_cu = 0;
        if (hipOccupancyMaxActiveBlocksPerMultiprocessor(&per_cu, (const void*)mk_fwd, NWAVES * 64, LDS_BYTES) != hipSuccess || per_cu < 1) fprintf(stderr, "kernel_launch: occupancy query says %d\n", per_cu);
        (void)hipGetLastError();
        grid = cus;
    }
    if (grid < 0) return;
    char* ws = (char*)d_ws; float* dout = (float*)d_out;
    (void)hipMemsetAsync(ws + W_CTL, 0, CTL_ZERO_BYTES, stream);
    MkArgs base{};
    for (int i = 0; i < 29; ++i) base.p[i] = d_in[i];
    base.p[29] = d_out; base.p[30] = d_ws; base.ph_lo = 0; base.ph_hi = 17; base.flags = 0; base.pad = 0;
    auto PH = [&](int lo, int hi, int flags) { MkArgs a = base; a.ph_lo = lo; a.ph_hi = hi; a.flags = flags; hipLaunchKernelGGL(mk_fwd, dim3(grid), dim3(NWAVES * 64), LDS_BYTES, stream, a); };
#if ONE_LAUNCH
    PH(0, 17, 0);
#else
    const float* x = (const float*)d_in[0]; const float* meta = (const float*)d_in[1];
    const float* w_in = (const float*)d_in[3]; const float* w_out = (const float*)d_in[4];
    const float* lam_re = (const float*)d_in[5]; const float* lam_im = (const float*)d_in[6]; const float* log_dt = (const float*)d_in[7];
    const float* b_re = (const float*)d_in[8]; const float* b_im = (const float*)d_in[9]; const float* c_re = (const float*)d_in[10]; const float* c_im = (const float*)d_in[11];
    const float* ssm_d = (const float*)d_in[12]; const float* w_glu = (const float*)d_in[13];
    const float* subln_g = (const float*)d_in[18]; const float* fox_b = (const float*)d_in[19]; const float* norm_ffn_g = (const float*)d_in[20];
    const float* dw1 = (const float*)d_in[21]; const float* dw3 = (const float*)d_in[22]; const float* dw2 = (const float*)d_in[23];
    const float* wrt = (const float*)d_in[24]; const float* mw1 = (const float*)d_in[25]; const float* mw3 = (const float*)d_in[26]; const float* mw2 = (const float*)d_in[27];
    const float* final_g = (const float*)d_in[28];
    bf16_t* hbuf = (bf16_t*)(ws + W_H); bf16_t* zbuf = (bf16_t*)(ws + W_Z); bf16_t* mix = (bf16_t*)(ws + W_MIX);
    float* resm = (float*)(ws + W_RESM); float* fgb = (float*)(ws + W_FG); float* cum = (float*)(ws + W_CUM); float* gates = (float*)(ws + W_TOK);
    bf16_t* ybuf = (bf16_t*)(ws + W_H);
    const float* lamp = (const float*)(ws + W_TAB + T_LAM);
    const int MG = 16512;
    PH(0, 1, 0);
    for (int l = 0; l < 2; ++l) {
        const int pb = 1 + 8 * l, bits = (OPT_MASK >> (5 * l)) & 31;
        const bool o_in = bits & 1, o_ssm = bits & 2, o_att = bits & 4, o_out = bits & 8, o_ffn = bits & 16;
        RowSrc src{}; src.x = x; src.meta = meta; src.dout = dout; src.resm = resm; src.layer0 = (l == 0); src.pad = 0;
        RowSrc cur{}; cur.x = x; cur.meta = meta; cur.dout = dout; cur.resm = resm; cur.layer0 = 0; cur.pad = 0;
        const float* w_in_l = w_in + (size_t)l * D * INW;
        if (o_in) PH(pb, pb + 1, 0);
        else hipLaunchKernelGGL((k_gemm<EpiZ, false>), dim3(1024), dim3(512), 0, stream, (const bf16_t*)hbuf, D, w_in_l, (const float*)nullptr, INW, MG, ZW, D, EpiZ{zbuf});
        const int fl = (o_ssm ? 0 : 1) | (o_att ? 0 : 2);
        PH(pb + 1, pb + 2, fl);
        if (!o_ssm) {
            hipLaunchKernelGGL(k_ssm_naive, dim3(NB * 16), dim3(64), 0, stream, (const bf16_t*)zbuf, lam_re + l * 1024, lam_im + l * 1024, log_dt + l * 16,
                               b_re + (size_t)l * 16384, b_im + (size_t)l * 16384, c_re + (size_t)l * 16384, c_im + (size_t)l * 16384, ssm_d + l * 256, ybuf);
            hipLaunchKernelGGL((k_gemm<EpiGlu, true>), dim3(1024), dim3(512), 0, stream, (const bf16_t*)ybuf, 256, w_glu + (size_t)l * 256 * 512, w_glu + (size_t)l * 256 * 512 + 256, 512, MG, 256, 256, EpiGlu{mix});
        }
        if (!o_att) hipLaunchKernelGGL(k_attn_naive_l, dim3(4096), dim3(256), 0, stream, (const bf16_t*)zbuf, (const float*)cum, (const float*)(lamp + 2 * l), subln_g + l * 128, mix);
        if (o_ssm || o_att) PH(pb + 2, pb + 3, fl);
        if (o_out) PH(pb + 3, pb + 4, 0);
        else hipLaunchKernelGGL((k_gemm<EpiRes, false>), dim3(1024), dim3(512), 0, stream, (const bf16_t*)mix, D, w_out + (size_t)l * D * D, (const float*)nullptr, D, MG, D, D, EpiRes{src, dout, resm});
        if (l == 0) {
            PH(pb + 4, pb + 5, 0);
            if (o_ffn) { PH(pb + 5, pb + 6, 0); PH(pb + 6, pb + 7, 0); }
            else {
                bf16_t* hn = (bf16_t*)(ws + W_HD);
                hipLaunchKernelGGL((k_gemm<EpiSwiglu, true>), dim3(1024), dim3(512), 0, stream, (const bf16_t*)hbuf, D, dw1, dw3, FFD, MG, FFD, D, EpiSwiglu{hn, FFD, 0});
                hipLaunchKernelGGL((k_gemm<EpiRes, false>), dim3(1024), dim3(512), 0, stream, (const bf16_t*)hn, FFD, dw2, (const float*)nullptr, D, MG, D, FFD, EpiRes{cur, dout, resm});
            }
            PH(pb + 7, pb + 8, 0);
        } else {
            if (o_ffn) { PH(pb + 4, pb + 5, 0); PH(pb + 5, pb + 6, 0); PH(pb + 6, pb + 7, 0); PH(pb + 7, pb + 8, 0); }
            else {
                bf16_t* hn = (bf16_t*)(ws + W_HM);
                hipLaunchKernelGGL(k_norm, dim3(1024), dim3(256), 0, stream, cur, norm_ffn_g + D, (const float*)nullptr, hbuf, fgb, wrt, gates);
                for (int e = 0; e < NE; ++e) {
                    hipLaunchKernelGGL((k_gemm<EpiSwiglu, true>), dim3(1024), dim3(512), 0, stream, (const bf16_t*)hbuf, D, mw1 + (size_t)e * D * FFE, mw3 + (size_t)e * D * FFE, FFE, MAIN, FFE, D, EpiSwiglu{hn, FFE, 0});
                    hipLaunchKernelGGL((k_gemm<EpiMoeDown, false>), dim3(1024), dim3(512), 0, stream, (const bf16_t*)hn, FFE, mw2 + (size_t)e * FFE * D, (const float*)nullptr, D, MAIN, D, FFE, EpiMoeDown{gates, dout, e, 0});
                }
                hipLaunchKernelGGL(k_final, dim3(1024), dim3(256), 0, stream, dout, final_g);
            }
        }
    }
#endif
}
```
